# Optimizing an MI355X kernel written in HIP

```python
import jax
import jax.numpy as jnp
from jax import lax
import numpy as np


D_MODEL = 1024
BATCH = 4
SEQ = 8192
DEPTH = 2
DEC_BATCH = 8
DEC_SEQ = 2048
PAST_LEN = 128

GRID_W = 64
NA_HEADS = 8
NA_HEAD_DIM = 64
NA_WIDTH = NA_HEADS * NA_HEAD_DIM
NA_WIN_ROWS = 8
NA_WIN_COLS = 16
RW_HEADS = 8
RW_HEAD_DIM = 64
RW_WIDTH = RW_HEADS * RW_HEAD_DIM
DECAY_LORA = 64
AAA_LORA = 64
GATE_LORA = 160
MEM_TOKENS = 256
MEM_HEADS = 4
MEM_HEAD_DIM = 128
MEM_WIDTH = MEM_HEADS * MEM_HEAD_DIM
BRANCH_WIDTH = 512
N_BRANCH = 3
D_FF = 2816
RMS_EPS = 1e-6
GN_EPS = 64e-5
RW_COLS = 3 * RW_WIDTH + 2 * DECAY_LORA + 2 * AAA_LORA + GATE_LORA
IN_COLS = 3 * NA_WIDTH + RW_COLS + MEM_WIDTH + N_BRANCH * D_MODEL

kernel_name = 'hybrid_natten_rwkv7_memory_encoder'


def rmsnorm(x, gain):
    xf = x.astype(jnp.float32)
    y = xf * lax.rsqrt(jnp.mean(xf * xf, axis=-1, keepdims=True) + RMS_EPS)
    return (y * gain.astype(jnp.float32)).astype(x.dtype)


def dwconv3(u, w):
    up = jnp.pad(u, ((0, 0), (1, 1), (0, 0)))
    return up[:, :-2] * w[0] + up[:, 1:-1] * w[1] + up[:, 2:] * w[2]


def neighbourhood_attention(q, k, v, rpb):
    bsz, l = q.shape[0], q.shape[1]
    rows = l // GRID_W
    wr = min(NA_WIN_ROWS, rows)
    wc = NA_WIN_COLS
    qg = q.reshape(bsz, rows, GRID_W, NA_HEADS, NA_HEAD_DIM)
    kg = k.reshape(bsz, rows, GRID_W, NA_HEADS, NA_HEAD_DIM)
    vg = v.reshape(bsz, rows, GRID_W, NA_HEADS, NA_HEAD_DIM)
    cols = np.arange(GRID_W)
    c0 = np.clip(cols - wc // 2, 0, GRID_W - wc)
    col_idx = c0[:, None] + np.arange(wc)[None, :]
    col_off = col_idx - cols[:, None] + (NA_WIN_COLS - 1)
    rpb_c = rpb[:, :, col_off]
    scale = NA_HEAD_DIM ** -0.5

    def row_block(i):
        r0 = jnp.clip(i - wr // 2, 0, rows - wr)
        q_row = lax.dynamic_index_in_dim(qg, i, axis=1, keepdims=False)
        k_band = lax.dynamic_slice_in_dim(kg, r0, wr, axis=1)
        v_band = lax.dynamic_slice_in_dim(vg, r0, wr, axis=1)
        k_win = k_band[:, :, col_idx]
        v_win = v_band[:, :, col_idx]
        row_off = r0 + jnp.arange(wr) - i + (NA_WIN_ROWS - 1)
        bias = jnp.take(rpb_c, row_off, axis=1).transpose(0, 2, 1, 3)
        s = jnp.einsum('bqhd,brqchd->bhqrc', q_row, k_win).astype(jnp.float32) * scale
        s = s + bias[None].astype(jnp.float32)
        p = jax.nn.softmax(s.reshape(bsz, NA_HEADS, GRID_W, wr * wc), axis=-1)
        p = p.reshape(s.shape).astype(v.dtype)
        return jnp.einsum('bhqrc,brqchd->bqhd', p, v_win)

    out = lax.map(row_block, jnp.arange(rows))
    return out.transpose(1, 0, 2, 3, 4).reshape(bsz, l, NA_WIDTH)


def wkv7_scan(r, w, k, v, a, b, reverse):
    bsz = r.shape[0]
    s0 = jnp.zeros((bsz, RW_HEADS, RW_HEAD_DIM, RW_HEAD_DIM), jnp.float32)

    def step(s, inp):
        r_t, w_t, k_t, v_t, a_t, b_t = inp
        sa = jnp.einsum('bhij,bhj->bhi', s, a_t)
        s = s * w_t[:, :, None, :] + sa[..., None] * b_t[:, :, None, :] + v_t[..., None] * k_t[:, :, None, :]
        return s, jnp.einsum('bhij,bhj->bhi', s, r_t)

    xs = tuple(t.transpose(1, 0, 2, 3) for t in (r, w, k, v, a, b))
    _, y = lax.scan(step, s0, xs, reverse=reverse)
    return y.transpose(1, 0, 2, 3)


def rwkv7_bidirectional(z, conv_w, decay0, decay2, a0, a2, g2, k_k, k_a, r_k, lnx_w, lnx_b):
    bsz, l = z.shape[0], z.shape[1]
    zf = dwconv3(z, conv_w).astype(jnp.float32)
    o1 = RW_WIDTH
    o2 = 2 * RW_WIDTH
    o3 = 3 * RW_WIDTH
    o4 = o3 + 2 * DECAY_LORA
    o5 = o4 + 2 * AAA_LORA
    r, k, v, xw, xa, xg = jnp.split(zf, [o1, o2, o3, o4, o5], axis=-1)

    def heads(t):
        return t.reshape(bsz, l, RW_HEADS, RW_HEAD_DIM)

    kk = heads(k * k_k)
    kk = kk * lax.rsqrt(jnp.maximum(jnp.sum(kk * kk, axis=-1, keepdims=True), 1e-24))
    rh = heads(r)
    vh = heads(v)
    g = jax.nn.sigmoid(xg) @ g2
    ys = []
    bonus = []
    for d in range(2):
        xw_d = xw[..., d * DECAY_LORA:(d + 1) * DECAY_LORA]
        xa_d = xa[..., d * AAA_LORA:(d + 1) * AAA_LORA]
        w_log = -jax.nn.softplus(-(decay0[d] + jnp.tanh(xw_d) @ decay2[d])) - 0.5
        decay = heads(jnp.exp(-jnp.exp(w_log)))
        a = jax.nn.sigmoid(a0[d] + xa_d @ a2[d])
        k_d = heads(k * (1.0 + (a - 1.0) * k_a))
        a_h = heads(a)
        ys.append(wkv7_scan(rh, decay, k_d, vh, -kk, kk * a_h, reverse=(d == 1)))
        bonus.append(jnp.sum(rh * k_d * r_k, axis=-1, keepdims=True) * vh)
    y = ys[0] + ys[1]
    mu = jnp.mean(y, axis=-1, keepdims=True)
    var = jnp.mean(jnp.square(y - mu), axis=-1, keepdims=True)
    y = ((y - mu) * lax.rsqrt(var + GN_EPS)).reshape(bsz, l, RW_WIDTH)
    y = y * lnx_w + lnx_b + (bonus[0] + bonus[1]).reshape(bsz, l, RW_WIDTH)
    return (y * g).astype(z.dtype)


def memory_cross_attention(q, mem_n, w_mem_kv):
    bsz, l = q.shape[0], q.shape[1]
    km, vm = jnp.split(mem_n @ w_mem_kv, 2, axis=-1)
    qh = q.reshape(bsz, l, MEM_HEADS, MEM_HEAD_DIM)
    kh = km.reshape(bsz, MEM_TOKENS, MEM_HEADS, MEM_HEAD_DIM)
    vh = vm.reshape(bsz, MEM_TOKENS, MEM_HEADS, MEM_HEAD_DIM)
    s = jnp.einsum('blhd,bmhd->bhlm', qh, kh).astype(jnp.float32) * (MEM_HEAD_DIM ** -0.5)
    p = jax.nn.softmax(s, axis=-1).astype(q.dtype)
    return jnp.einsum('bhlm,bmhd->blhd', p, vh).reshape(bsz, l, MEM_WIDTH)


def encoder_layer(x, mem, attn_norm, w_in, na_rpb, rw_conv, rw_decay0, rw_decay2, rw_a0, rw_a2,
                  rw_g2, rw_k_k, rw_k_a, rw_r_k, rw_lnx_w, rw_lnx_b, mem_norm, w_mem_kv,
                  w_branch, w_out, ffn_norm, w_up, ffn_conv, ffn_conv_b, w_down):
    bsz, l = x.shape[0], x.shape[1]
    h = rmsnorm(x, attn_norm)
    z = h @ w_in
    c1 = 3 * NA_WIDTH
    c2 = c1 + RW_COLS
    c3 = c2 + MEM_WIDTH
    z_na, z_rw, z_mem, z_gate = jnp.split(z, [c1, c2, c3], axis=-1)
    q, k, v = (t.reshape(bsz, l, NA_HEADS, NA_HEAD_DIM) for t in jnp.split(z_na, 3, axis=-1))
    o_na = neighbourhood_attention(q, k, v, na_rpb)
    o_rw = rwkv7_bidirectional(z_rw, rw_conv, rw_decay0, rw_decay2, rw_a0, rw_a2, rw_g2,
                               rw_k_k, rw_k_a, rw_r_k, rw_lnx_w, rw_lnx_b)
    o_mem = memory_cross_attention(z_mem, rmsnorm(mem, mem_norm), w_mem_kv)
    gates = jax.nn.sigmoid(z_gate.astype(jnp.float32)).astype(x.dtype).reshape(bsz, l, N_BRANCH, D_MODEL)
    merged = (gates[:, :, 0] * (o_na @ w_branch[0])
              + gates[:, :, 1] * (o_rw @ w_branch[1])
              + gates[:, :, 2] * (o_mem @ w_branch[2]))
    x = x + merged @ w_out
    h = rmsnorm(x, ffn_norm)
    u = dwconv3(h @ w_up, ffn_conv) + ffn_conv_b
    u_val, u_gate = jnp.split(u, 2, axis=-1)
    return x + (jax.nn.silu(u_gate) * u_val) @ w_down


def encoder_trunk(x, mem, layer_params, final_norm):
    for i in range(DEPTH):
        x = encoder_layer(x, mem, *[p[i] for p in layer_params])
    return rmsnorm(x, final_norm)


def setup_inputs(seed: int = 0) -> dict:
    key = jax.random.key(seed)
    ks = jax.random.split(key, 32)
    f32 = jnp.float32

    def nrm(k, shape, scale):
        return jax.random.normal(k, shape, f32) * scale

    conv_base = jnp.array([0.2, 0.6, 0.2], f32)[None, :, None]
    return {
        'x_prompt': nrm(ks[0], (BATCH, SEQ, D_MODEL), 1.0),
        'x_sample': nrm(ks[1], (DEC_BATCH, DEC_SEQ, D_MODEL), 1.0),
        'mem_prompt': nrm(ks[2], (BATCH, MEM_TOKENS, D_MODEL), 1.0),
        'mem_sample': nrm(ks[3], (DEC_BATCH, MEM_TOKENS, D_MODEL), 1.0),
        'attn_norm': 1.0 + nrm(ks[4], (DEPTH, D_MODEL), 0.05),
        'w_in': nrm(ks[5], (DEPTH, D_MODEL, IN_COLS), D_MODEL ** -0.5),
        'na_rpb': nrm(ks[6], (DEPTH, NA_HEADS, 2 * NA_WIN_ROWS - 1, 2 * NA_WIN_COLS - 1), 0.3),
        'rw_conv': conv_base + nrm(ks[7], (DEPTH, 3, RW_COLS), 0.1),
        'rw_decay0': jax.random.uniform(ks[8], (DEPTH, 2, RW_WIDTH), f32, -6.0, 1.0),
        'rw_decay2': nrm(ks[9], (DEPTH, 2, DECAY_LORA, RW_WIDTH), 0.1),
        'rw_a0': nrm(ks[10], (DEPTH, 2, RW_WIDTH), 0.5),
        'rw_a2': nrm(ks[11], (DEPTH, 2, AAA_LORA, RW_WIDTH), AAA_LORA ** -0.5),
        'rw_g2': nrm(ks[12], (DEPTH, GATE_LORA, RW_WIDTH), GATE_LORA ** -0.5),
        'rw_k_k': 0.85 + nrm(ks[13], (DEPTH, RW_WIDTH), 0.05),
        'rw_k_a': 1.0 + nrm(ks[14], (DEPTH, RW_WIDTH), 0.05),
        'rw_r_k': nrm(ks[15], (DEPTH, RW_HEADS, RW_HEAD_DIM), 0.1),
        'rw_lnx_w': 1.0 + nrm(ks[16], (DEPTH, RW_WIDTH), 0.05),
        'rw_lnx_b': nrm(ks[17], (DEPTH, RW_WIDTH), 0.01),
        'mem_norm': 1.0 + nrm(ks[18], (DEPTH, D_MODEL), 0.05),
        'w_mem_kv': nrm(ks[19], (DEPTH, D_MODEL, 2 * MEM_WIDTH), D_MODEL ** -0.5),
        'w_branch': nrm(ks[20], (DEPTH, N_BRANCH, BRANCH_WIDTH, D_MODEL), BRANCH_WIDTH ** -0.5),
        'w_out': nrm(ks[21], (DEPTH, D_MODEL, D_MODEL), D_MODEL ** -0.5),
        'ffn_norm': 1.0 + nrm(ks[22], (DEPTH, D_MODEL), 0.05),
        'w_up': nrm(ks[23], (DEPTH, D_MODEL, 2 * D_FF), D_MODEL ** -0.5),
        'ffn_conv': conv_base + nrm(ks[24], (DEPTH, 3, 2 * D_FF), 0.1),
        'ffn_conv_b': nrm(ks[25], (DEPTH, 2 * D_FF), 0.01),
        'w_down': nrm(ks[26], (DEPTH, D_FF, D_MODEL), D_FF ** -0.5),
        'final_norm': 1.0 + nrm(ks[27], (D_MODEL,), 0.05),
    }


def reference(x_prompt, x_sample, mem_prompt, mem_sample, attn_norm, w_in, na_rpb, rw_conv,
              rw_decay0, rw_decay2, rw_a0, rw_a2, rw_g2, rw_k_k, rw_k_a, rw_r_k, rw_lnx_w,
              rw_lnx_b, mem_norm, w_mem_kv, w_branch, w_out, ffn_norm, w_up, ffn_conv,
              ffn_conv_b, w_down, final_norm):
    layer_params = (attn_norm, w_in, na_rpb, rw_conv, rw_decay0, rw_decay2, rw_a0, rw_a2,
                    rw_g2, rw_k_k, rw_k_a, rw_r_k, rw_lnx_w, rw_lnx_b, mem_norm, w_mem_kv,
                    w_branch, w_out, ffn_norm, w_up, ffn_conv, ffn_conv_b, w_down)
    y_prompt = encoder_trunk(x_prompt, mem_prompt, layer_params, final_norm)
    y_sample = encoder_trunk(x_sample, mem_sample, layer_params, final_norm)
    return (y_prompt, y_sample)
```

```cpp
#include <hip/hip_runtime.h>
#include <hip/hip_cooperative_groups.h>
#include <stdint.h>
#include <stdio.h>
namespace cg = cooperative_groups;

#ifndef SINGLE_LAUNCH
#define SINGLE_LAUNCH 1
#endif

typedef unsigned short u16;
typedef __attribute__((ext_vector_type(8))) short bf16x8;
typedef __attribute__((ext_vector_type(16))) float f32x16;
#define DI __device__ __forceinline__
#define MFMA(a, b, c) __builtin_amdgcn_mfma_f32_32x32x16_bf16((a), (b), (c), 0, 0, 0)

constexpr int TP = 32768, TS = 16384, T = 49152;
constexpr int IN_COLS = 7072, RW_COLS = 1952, DFF = 2816;
constexpr float RMS_EPS = 1e-6f, GN_EPS = 64e-5f;
constexpr int LDS_BYTES = 75776;
constexpr int AUX = 73728;

constexpr size_t UNIT = (size_t)T * 512 * 2;
constexpr size_t OFF_WIN = 0;
constexpr size_t OFF_WBR = OFF_WIN + (size_t)2 * 7072 * 1024 * 2;
constexpr size_t OFF_WOUT = OFF_WBR + (size_t)2 * 3 * 1024 * 512 * 2;
constexpr size_t OFF_WUP = OFF_WOUT + (size_t)2 * 1024 * 1024 * 2;
constexpr size_t OFF_WDN = OFF_WUP + (size_t)2 * 5632 * 1024 * 2;
constexpr size_t OFF_WMKV = OFF_WDN + (size_t)2 * 1024 * 2816 * 2;
constexpr size_t OFF_KM = OFF_WMKV + (size_t)2 * 1024 * 1024 * 2;
constexpr size_t OFF_VMT = OFF_KM + (size_t)12 * 4 * 256 * 128 * 2;
constexpr size_t OFF_BON = OFF_VMT + (size_t)12 * 4 * 256 * 128 * 2;
constexpr size_t OFF_CNT = OFF_BON + (size_t)T * 8 * 2 * 4;
constexpr size_t OFF_RST = OFF_CNT + 1024;
constexpr size_t OFF_ACT0 = (size_t)88 * 1024 * 1024;
static_assert(OFF_RST + (size_t)T * 4 <= OFF_ACT0, "ws map");
constexpr size_t OFF_QN = OFF_ACT0;
constexpr size_t OFF_KN = OFF_ACT0 + UNIT;
constexpr size_t OFF_VTN = OFF_ACT0 + 2 * UNIT;
constexpr size_t OFF_QM = OFF_ACT0 + 3 * UNIT;
constexpr size_t OFF_RR = OFF_ACT0 + 4 * UNIT;
constexpr size_t OFF_KR = OFF_ACT0 + 5 * UNIT;
constexpr size_t OFF_VR = OFF_ACT0 + 6 * UNIT;
constexpr size_t OFF_XW = OFF_ACT0 + 7 * UNIT;
constexpr size_t OFF_XA = OFF_XW + (size_t)T * 128 * 2;
constexpr size_t OFF_XG = OFF_XA + (size_t)T * 128 * 2;
constexpr size_t OFF_END = OFF_XG + (size_t)T * 160 * 2;
static_assert(OFF_END <= (size_t)512 * 1024 * 1024, "ws too big");
constexpr size_t OFF_XB = OFF_ACT0 + 11 * (UNIT / 2);
static_assert(OFF_XB + 2 * UNIT <= OFF_END, "xb");
constexpr size_t OFF_YF = OFF_KN, OFF_YB = OFF_VTN, OFF_ORW = OFF_RR, OFF_MERGED = OFF_KN, OFF_FFACT = OFF_ACT0;

struct Params {
  const float *x_prompt, *x_sample, *mem_prompt, *mem_sample;
  const float *attn_norm, *w_in, *na_rpb, *rw_conv, *rw_decay0, *rw_decay2, *rw_a0, *rw_a2, *rw_g2, *rw_k_k, *rw_k_a,
      *rw_r_k, *rw_lnx_w, *rw_lnx_b, *mem_norm, *w_mem_kv, *w_branch, *w_out, *ffn_norm, *w_up, *ffn_conv, *ffn_conv_b,
      *w_down, *final_norm;
  float* out;
  char* ws;
  int phase_lo, phase_hi;
};

typedef __bf16 bf2_t __attribute__((ext_vector_type(2)));
typedef float f2_t __attribute__((ext_vector_type(2)));
DI uint32_t pack2(float a, float b) {
  f2_t v = {a, b};
  return __builtin_bit_cast(uint32_t, __builtin_convertvector(v, bf2_t));
}
DI uint32_t pack2a(float a, float b) {
  uint32_t r;
  asm("s_nop 0\n\tv_cvt_pk_bf16_f32 %0, %1, %2" : "=v"(r) : "v"(a), "v"(b));
  return r;
}
DI float bflo(uint32_t u) { return __uint_as_float(u << 16); }
DI float bfhi(uint32_t u) { return __uint_as_float(u & 0xffff0000u); }
DI float bf1(u16 h) { return __uint_as_float(((uint32_t)h) << 16); }
DI u16 tobf(float a) { return (u16)(pack2(a, 0.f) & 0xffffu); }
DI u16 tobfa(float a) { return (u16)(pack2a(a, 0.f) & 0xffffu); }
DI int seq_start(int s) { return s < 4 ? s * 8192 : TP + (s - 4) * 2048; }
DI int seq_len(int s) { return s < 4 ? 8192 : 2048; }
DI int tok_seq(int tok) { return tok < TP ? (tok >> 13) : 4 + ((tok - TP) >> 11); }
DI const float* opq(const float* x) { asm volatile("" : "+s"(x)); return x; }
DI const float* xrow(const Params& p, int layer, int tok) {
  const float* a = opq(p.x_prompt);
  const float* b = opq(p.x_sample);
  const float* c = opq(p.out);
  if (layer == 0) return tok < TP ? a + (size_t)tok * 1024 : b + (size_t)(tok - TP) * 1024;
  return c + (size_t)tok * 1024;
}
DI int tidx() { int t = threadIdx.x; asm volatile("" : "+v"(t)); return t; }
DI int kperm(int r) { return (r & 0x13) | ((r & 4) << 1) | ((r & 8) >> 1); }
template <int N>
DI float row_ror(float v) {
  return __int_as_float(__builtin_amdgcn_update_dpp(0, __float_as_int(v), 0x120 + N, 0xf, 0xf, true));
}
DI float allsum16(float v) {
  v += row_ror<8>(v);
  v += row_ror<4>(v);
  v += row_ror<2>(v);
  v += row_ror<1>(v);
  return v;
}
DI float sigmoidf_(float x) { return __builtin_amdgcn_rcpf(1.f + __expf(-x)); }
DI float tanhf_(float x) { return 1.f - 2.f * __builtin_amdgcn_rcpf(__expf(2.f * x) + 1.f); }
DI void decode_tile(int id, int MT, int NT, int& mt, int& nt) {
  const int x = id & 7, j = id >> 3, LM = MT >> 3;
  const int full = 8 * NT, sr = j / full, rem = j - sr * full;
  int R = LM - 8 * sr;
  R = R > 8 ? 8 : R;
  const int ng = NT >> 3, gsz = R * 8;
  int lm8;
  if (rem < ng * gsz) {
    const int g = rem / gsz, r2 = rem - g * gsz;
    lm8 = r2 >> 3;
    nt = g * 8 + (r2 & 7);
  } else {
    const int r2 = rem - ng * gsz, w = NT - ng * 8;
    lm8 = r2 / w;
    nt = ng * 8 + (r2 - lm8 * w);
  }
  mt = (sr * 8 + lm8) * 8 + x;
}

struct F8 { float4 a, b; };
DI float ssq8(const uint4& v) {
  float s = 0.f, t;
  t = bflo(v.x); s += t * t; t = bfhi(v.x); s += t * t; t = bflo(v.y); s += t * t; t = bfhi(v.y); s += t * t;
  t = bflo(v.z); s += t * t; t = bfhi(v.z); s += t * t; t = bflo(v.w); s += t * t; t = bfhi(v.w); s += t * t;
  return s;
}
struct LoadBF {
  typedef uint4 Raw;
  const u16* base;
  int off[4];
  DI Raw load(int k, int i) const { return *(const uint4*)(base + off[i] + k); }
  DI uint4 finish(const Raw& v, int) { return v; }
};
template <int S32>
struct LoadBFc {
  typedef uint4 Raw;
  const u16* base;
  DI Raw load(int k, int i) const { return *(const uint4*)(base + i * S32 + k); }
  DI uint4 finish(const Raw& v, int) { return v; }
};
template <int S32>
struct LoadBF2c {
  typedef uint4 Raw;
  const u16 *base0, *base1;
  DI Raw load(int k, int i) const { return *(const uint4*)((i < 2 ? base0 : base1) + (i & 1) * S32 + k); }
  DI uint4 finish(const Raw& v, int) { return v; }
};
template <int S32>
struct LoadBFv {
  typedef uint4 Raw;
  const u16* base;
  unsigned valid;
  int voff;
  DI Raw load(int k, int i) const { return *(const uint4*)(base + (((valid >> i) & 1u) ? i * S32 : voff) + k); }
  DI uint4 finish(const Raw& v, int i) { return ((valid >> i) & 1u) ? v : make_uint4(0, 0, 0, 0); }
};
template <int S32>
struct LoadBFs {
  typedef uint4 Raw;
  const u16* base;
  unsigned valid;
  float ssq[4];
  DI Raw load(int k, int i) const {
    if (!((valid >> i) & 1u)) return make_uint4(0, 0, 0, 0);
    return *(const uint4*)(base + i * S32 + k);
  }
  DI uint4 finish(const Raw& v, int i) { ssq[i] += ssq8(v); return v; }
};
struct LoadF32 {
  typedef F8 Raw;
  const float* base;
  int off[4];
  unsigned valid;
  float ssq[4];
  DI Raw load(int k, int i) const {
    F8 r;
    if (!((valid >> i) & 1u)) { r.a = make_float4(0, 0, 0, 0); r.b = r.a; return r; }
    const float4* p = (const float4*)(base + off[i] + k);
    r.a = p[0]; r.b = p[1];
    return r;
  }
  DI uint4 finish(const Raw& r, int i) {
    const float4 a = r.a, b = r.b;
    ssq[i] += a.x * a.x + a.y * a.y + a.z * a.z + a.w * a.w + b.x * b.x + b.y * b.y + b.z * b.z + b.w * b.w;
    return make_uint4(pack2(a.x, a.y), pack2(a.z, a.w), pack2(b.x, b.y), pack2(b.z, b.w));
  }
};
template <int S32>
struct LoadF32c {
  typedef F8 Raw;
  const float* base;
  float ssq[4];
  DI Raw load(int k, int i) const {
    F8 r;
    const float4* p = (const float4*)(base + i * S32 + k);
    r.a = p[0]; r.b = p[1];
    return r;
  }
  DI uint4 finish(const Raw& r, int i) {
    const float4 a = r.a, b = r.b;
    ssq[i] += a.x * a.x + a.y * a.y + a.z * a.z + a.w * a.w + b.x * b.x + b.y * b.y + b.z * b.z + b.w * b.w;
    return make_uint4(pack2(a.x, a.y), pack2(a.z, a.w), pack2(b.x, b.y), pack2(b.z, b.w));
  }
};

template <int NPRE, class LA, class LB>
DI void gemm_mainloop(LA& la, LB& lb, int ktiles, f32x16 (&acc)[2][2], char* smem) {
  const int tid = tidx(), lane = tid & 63, wave = tid >> 6;
  const int wm = wave & 1, wn = wave >> 1, r = lane & 31, h = lane >> 5;
  const int lrow = tid >> 3, lkc = tid & 7;
  const int wofs = lrow * 144 + lkc * 16;
  const int aofs = (wm * 64 + r) * 144 + h * 16, bofs = 18432 + (wn * 64 + r) * 144 + h * 16;
  typename LA::Raw ra[NPRE][4];
  typename LB::Raw rb[NPRE][4];
#pragma unroll
  for (int i = 0; i < 4; ++i) {
    ra[0][i] = la.load(lkc * 8, i);
    rb[0][i] = lb.load(lkc * 8, i);
  }
  __syncthreads();
#pragma unroll
  for (int i = 0; i < 4; ++i) {
    *(uint4*)(smem + wofs + i * 4608) = la.finish(ra[0][i], i);
    *(uint4*)(smem + 18432 + wofs + i * 4608) = lb.finish(rb[0][i], i);
  }
#pragma unroll
  for (int pz = 0; pz < NPRE; ++pz) {
    if (pz + 1 < ktiles) {
#pragma unroll
      for (int i = 0; i < 4; ++i) {
        ra[pz][i] = la.load((pz + 1) * 64 + lkc * 8, i);
        rb[pz][i] = lb.load((pz + 1) * 64 + lkc * 8, i);
      }
    }
  }
  __syncthreads();
  for (int kt0 = 0; kt0 < ktiles; kt0 += NPRE) {
#pragma unroll
    for (int u = 0; u < NPRE; ++u) {
      const int kt = kt0 + u;
      char* cur = smem + (kt & 1) * 36864;
      char* nxt = smem + ((kt + 1) & 1) * 36864;
#pragma unroll
      for (int ks = 0; ks < 4; ++ks) {
        bf16x8 af[2], bfr[2];
#pragma unroll
        for (int mt = 0; mt < 2; ++mt) af[mt] = *(const bf16x8*)(cur + aofs + mt * 4608 + ks * 32);
#pragma unroll
        for (int nt = 0; nt < 2; ++nt) bfr[nt] = *(const bf16x8*)(cur + bofs + nt * 4608 + ks * 32);
#pragma unroll
        for (int mt = 0; mt < 2; ++mt)
#pragma unroll
          for (int nt = 0; nt < 2; ++nt) acc[mt][nt] = MFMA(af[mt], bfr[nt], acc[mt][nt]);
      }
      if (kt + 1 < ktiles) {
#pragma unroll
        for (int i = 0; i < 4; ++i) {
          *(uint4*)(nxt + wofs + i * 4608) = la.finish(ra[u][i], i);
          *(uint4*)(nxt + 18432 + wofs + i * 4608) = lb.finish(rb[u][i], i);
        }
        if (kt + 1 + NPRE < ktiles) {
#pragma unroll
          for (int i = 0; i < 4; ++i) {
            ra[u][i] = la.load((kt + 1 + NPRE) * 64 + lkc * 8, i);
            rb[u][i] = lb.load((kt + 1 + NPRE) * 64 + lkc * 8, i);
          }
        }
      }
      __syncthreads();
    }
  }
}

DI void zero_acc(f32x16 (&acc)[2][2]);
template <int NPRE, class LA, class LB, class SetupF, class EpiF>
DI void gemm_tiles(int ktiles, int id0, int stride, int idend, SetupF setup, EpiF epi, char* smem) {
  if (id0 >= idend) return;
  const int tid = tidx(), lane = tid & 63, wave = tid >> 6;
  const int wm = wave & 1, wn = wave >> 1, r = lane & 31, h = lane >> 5;
  const int lrow = tid >> 3, lkc = tid & 7;
  const int wofs = lrow * 144 + lkc * 16;
  const int aofs = (wm * 64 + r) * 144 + h * 16, bofs = 18432 + (wn * 64 + r) * 144 + h * 16;
  LA la, lan;
  LB lb, lbn;
  typename LA::Raw ra[NPRE][4];
  typename LB::Raw rb[NPRE][4];
  setup(id0, la, lb);
#pragma unroll
  for (int i = 0; i < 4; ++i) {
    ra[0][i] = la.load(lkc * 8, i);
    rb[0][i] = lb.load(lkc * 8, i);
  }
  __syncthreads();
#pragma unroll
  for (int i = 0; i < 4; ++i) {
    *(uint4*)(smem + wofs + i * 4608) = la.finish(ra[0][i], i);
    *(uint4*)(smem + 18432 + wofs + i * 4608) = lb.finish(rb[0][i], i);
  }
#pragma unroll
  for (int pz = 0; pz < NPRE; ++pz) {
#pragma unroll
    for (int i = 0; i < 4; ++i) {
      ra[pz][i] = la.load((pz + 1) * 64 + lkc * 8, i);
      rb[pz][i] = lb.load((pz + 1) * 64 + lkc * 8, i);
    }
  }
  __syncthreads();
  for (int id = id0; id < idend; id += stride) {
    const int idn = id + stride;
    const bool has_next = idn < idend;
    if (has_next) setup(idn, lan, lbn);
    f32x16 acc[2][2];
    zero_acc(acc);
    for (int kt0 = 0; kt0 < ktiles; kt0 += NPRE) {
#pragma unroll
      for (int u = 0; u < NPRE; ++u) {
        const int kt = kt0 + u;
        char* cur = smem + (kt & 1) * 36864;
        char* nxt = smem + ((kt + 1) & 1) * 36864;
#pragma unroll
        for (int ks = 0; ks < 4; ++ks) {
          bf16x8 af[2], bfr[2];
#pragma unroll
          for (int mt = 0; mt < 2; ++mt) af[mt] = *(const bf16x8*)(cur + aofs + mt * 4608 + ks * 32);
#pragma unroll
          for (int nt = 0; nt < 2; ++nt) bfr[nt] = *(const bf16x8*)(cur + bofs + nt * 4608 + ks * 32);
#pragma unroll
          for (int mt = 0; mt < 2; ++mt)
#pragma unroll
            for (int nt = 0; nt < 2; ++nt) acc[mt][nt] = MFMA(af[mt], bfr[nt], acc[mt][nt]);
        }
        if (kt + 1 < ktiles) {
#pragma unroll
          for (int i = 0; i < 4; ++i) {
            *(uint4*)(nxt + wofs + i * 4608) = la.finish(ra[u][i], i);
            *(uint4*)(nxt + 18432 + wofs + i * 4608) = lb.finish(rb[u][i], i);
          }
        } else if (has_next) {
#pragma unroll
          for (int i = 0; i < 4; ++i) {
            *(uint4*)(nxt + wofs + i * 4608) = lan.finish(ra[u][i], i);
            *(uint4*)(nxt + 18432 + wofs + i * 4608) = lbn.finish(rb[u][i], i);
          }
        }
        const int q = kt + 1 + NPRE;
        if (q < ktiles) {
#pragma unroll
          for (int i = 0; i < 4; ++i) {
            ra[u][i] = la.load(q * 64 + lkc * 8, i);
            rb[u][i] = lb.load(q * 64 + lkc * 8, i);
          }
        } else if (has_next) {
#pragma unroll
          for (int i = 0; i < 4; ++i) {
            ra[u][i] = lan.load((q - ktiles) * 64 + lkc * 8, i);
            rb[u][i] = lbn.load((q - ktiles) * 64 + lkc * 8, i);
          }
        }
        __syncthreads();
      }
    }
    epi(id, acc, la);
    la = lan;
    lb = lbn;
  }
}

DI void zero_acc(f32x16 (&acc)[2][2]) {
#pragma unroll
  for (int a = 0; a < 2; ++a)
#pragma unroll
    for (int b = 0; b < 2; ++b)
#pragma unroll
      for (int i = 0; i < 16; ++i) acc[a][b][i] = 0.f;
}

template <class LA>
DI void write_rstd(LA& la, char* smem) {
  float* rs = (float*)(smem + AUX);
  const int tid = tidx();
#pragma unroll
  for (int i = 0; i < 4; ++i) {
    float s = la.ssq[i];
    s += __shfl_xor(s, 1);
    s += __shfl_xor(s, 2);
    s += __shfl_xor(s, 4);
    if ((tid & 7) == 0) rs[(tid >> 3) + 32 * i] = rsqrtf(s * (1.f / 1024.f) + RMS_EPS);
  }
  __syncthreads();
}

template <class F>
DI void epi_foreach(const f32x16 (&acc)[2][2], F f) {
  const int tid_ = tidx(); const int lane = tid_ & 63, wave = tid_ >> 6;
  const int wm = wave & 1, wn = wave >> 1, r = lane & 31, h = lane >> 5;
#pragma unroll
  for (int mt = 0; mt < 2; ++mt)
#pragma unroll
    for (int nt = 0; nt < 2; ++nt)
#pragma unroll
      for (int i = 0; i < 16; ++i) {
        int row = wm * 64 + mt * 32 + (i & 3) + 8 * (i >> 2) + 4 * h;
        int col = wn * 64 + nt * 32 + r;
        f(row, col, acc[mt][nt][i]);
      }
}

DI void convert_matrix(const float* src, int ld, int K, int N, const float* gain, u16* dst, char* smem) {
  float* tl = (float*)smem;
  const int tid = tidx();
  const int nk = K / 64, tiles = (N / 32) * nk;
  const int kk = tid >> 3, n4 = (tid & 7) * 4;
  float4 nv[2];
  float ng[2];
  auto issue = [&](int t) {
    const int n0 = (t / nk) * 32, k0 = (t % nk) * 64;
#pragma unroll
    for (int rep = 0; rep < 2; ++rep) {
      const int k = kk + 32 * rep;
      nv[rep] = *(const float4*)(src + (size_t)(k0 + k) * ld + n0 + n4);
      ng[rep] = gain ? gain[k0 + k] : 1.f;
    }
  };
  int t = blockIdx.x;
  if (t < tiles) issue(t);
  for (; t < tiles; t += gridDim.x) {
    const int n0 = (t / nk) * 32, k0 = (t % nk) * 64;
    const float4 v0 = nv[0], v1 = nv[1];
    const float g0 = ng[0], g1 = ng[1];
    if (t + (int)gridDim.x < tiles) issue(t + gridDim.x);
    tl[kk * 33 + n4 + 0] = v0.x * g0;
    tl[kk * 33 + n4 + 1] = v0.y * g0;
    tl[kk * 33 + n4 + 2] = v0.z * g0;
    tl[kk * 33 + n4 + 3] = v0.w * g0;
    tl[(kk + 32) * 33 + n4 + 0] = v1.x * g1;
    tl[(kk + 32) * 33 + n4 + 1] = v1.y * g1;
    tl[(kk + 32) * 33 + n4 + 2] = v1.z * g1;
    tl[(kk + 32) * 33 + n4 + 3] = v1.w * g1;
    __syncthreads();
    const int n = tid >> 3, kc = tid & 7;
    float e[8];
#pragma unroll
    for (int j = 0; j < 8; ++j) e[j] = tl[(kc * 8 + j) * 33 + n];
    *(uint4*)(dst + (size_t)(n0 + n) * K + k0 + kc * 8) =
        make_uint4(pack2(e[0], e[1]), pack2(e[2], e[3]), pack2(e[4], e[5]), pack2(e[6], e[7]));
    __syncthreads();
  }
}

DI void phase_convert(const Params& p, char* smem) {
  for (int l = 0; l < 2; ++l) {
    convert_matrix(p.w_in + (size_t)l * 1024 * IN_COLS, IN_COLS, 1024, IN_COLS, p.attn_norm + l * 1024,
                   (u16*)(p.ws + OFF_WIN) + (size_t)l * IN_COLS * 1024, smem);
    for (int i = 0; i < 3; ++i)
      convert_matrix(p.w_branch + (size_t)(l * 3 + i) * 512 * 1024, 1024, 512, 1024, nullptr,
                     (u16*)(p.ws + OFF_WBR) + (size_t)(l * 3 + i) * 1024 * 512, smem);
    convert_matrix(p.w_out + (size_t)l * 1024 * 1024, 1024, 1024, 1024, nullptr, (u16*)(p.ws + OFF_WOUT) + (size_t)l * 1024 * 1024, smem);
    convert_matrix(p.w_up + (size_t)l * 1024 * 5632, 5632, 1024, 5632, p.ffn_norm + l * 1024,
                   (u16*)(p.ws + OFF_WUP) + (size_t)l * 5632 * 1024, smem);
    convert_matrix(p.w_down + (size_t)l * 2816 * 1024, 1024, 2816, 1024, nullptr, (u16*)(p.ws + OFF_WDN) + (size_t)l * 1024 * 2816, smem);
    convert_matrix(p.w_mem_kv + (size_t)l * 1024 * 1024, 1024, 1024, 1024, p.mem_norm + l * 1024,
                   (u16*)(p.ws + OFF_WMKV) + (size_t)l * 1024 * 1024, smem);
  }
}

DI void phase_inproj(const Params& p, int layer, char* smem) {
  const int tid = tidx(), lane = tid & 63, wave = tid >> 6;
  const int wm = wave & 1, wn = wave >> 1, r = lane & 31, h = lane >> 5;
  const u16* W = (const u16*)(p.ws + OFF_WIN) + (size_t)layer * IN_COLS * 1024;
  const u16* WM = (const u16*)(p.ws + OFF_WMKV) + (size_t)layer * 1024 * 1024;
  const float* rs = (const float*)(smem + AUX);
  const int lrow = tid >> 3;
  constexpr int NMAIN = 384 * 32;
  for (int id = blockIdx.x; id < NMAIN + 192; id += gridDim.x) {
    f32x16 acc[2][2];
    zero_acc(acc);
    if (id < NMAIN) {
      LoadF32c<32 * 1024> la;
      LoadBFc<32 * 1024> lb;
      int mt, nt;
      decode_tile(id, 384, 32, mt, nt);
      const int tok0 = mt * 128;
      const int src0 = nt < 28 ? nt * 128 : 3488 + (nt - 28) * 128;
      const int nvalid = nt == 27 ? 32 : 128;
      la.base = xrow(p, layer, tok0) + (size_t)lrow * 1024;
      lb.base = W + (size_t)(src0 + lrow) * 1024;
#pragma unroll
      for (int i = 0; i < 4; ++i) la.ssq[i] = 0.f;
      gemm_mainloop<1>(la, lb, 16, acc, smem);
      write_rstd(la, smem);
      if (nt >= 8 && nt < 12) {
        const int seq = tok_seq(tok0), L = seq_len(seq), t0 = tok0 - seq_start(seq);
        u16* vt = (u16*)(p.ws + OFF_VTN) + (size_t)seq_start(seq) * 512;
#pragma unroll
        for (int mt2 = 0; mt2 < 2; ++mt2)
#pragma unroll
          for (int nt2 = 0; nt2 < 2; ++nt2)
#pragma unroll
            for (int g = 0; g < 4; ++g) {
              int row = wm * 64 + mt2 * 32 + 8 * g + 4 * h;
              int col = (nt - 8) * 128 + wn * 64 + nt2 * 32 + r;
              float v0 = acc[mt2][nt2][4 * g + 0] * rs[row + 0], v1 = acc[mt2][nt2][4 * g + 1] * rs[row + 1];
              float v2 = acc[mt2][nt2][4 * g + 2] * rs[row + 2], v3 = acc[mt2][nt2][4 * g + 3] * rs[row + 3];
              *(uint2*)(vt + (size_t)col * L + t0 + row) = make_uint2(pack2(v0, v1), pack2(v2, v3));
            }
      } else {
        u16* dst;
        int ld, c0;
        if (nt < 4) { dst = (u16*)(p.ws + OFF_QN); ld = 512; c0 = nt * 128; }
        else if (nt < 8) { dst = (u16*)(p.ws + OFF_KN); ld = 512; c0 = (nt - 4) * 128; }
        else if (nt < 16) { dst = (u16*)(p.ws + OFF_RR); ld = 512; c0 = (nt - 12) * 128; }
        else if (nt < 20) { dst = (u16*)(p.ws + OFF_KR); ld = 512; c0 = (nt - 16) * 128; }
        else if (nt < 24) { dst = (u16*)(p.ws + OFF_VR); ld = 512; c0 = (nt - 20) * 128; }
        else if (nt == 24) { dst = (u16*)(p.ws + OFF_XW); ld = 128; c0 = 0; }
        else if (nt == 25) { dst = (u16*)(p.ws + OFF_XA); ld = 128; c0 = 0; }
        else if (nt < 28) { dst = (u16*)(p.ws + OFF_XG); ld = 160; c0 = (nt - 26) * 128; }
        else { dst = (u16*)(p.ws + OFF_QM); ld = 512; c0 = (nt - 28) * 128; }
        epi_foreach(acc, [&](int row, int col, float v) {
          if (col < nvalid) dst[(size_t)(tok0 + row) * ld + c0 + col] = tobf(v * rs[row]);
        });
      }
    } else {
      LoadF32 la;
      LoadBF lb;
      const int id2 = id - NMAIN, mt = id2 >> 3, nt = id2 & 7;
      const int seq = mt >> 1;
      {
        const int mr0 = mt * 128 + lrow;
        la.base = (mt < 8 ? opq(p.mem_prompt) + (size_t)mr0 * 1024 : opq(p.mem_sample) + (size_t)(mr0 - 1024) * 1024);
      }
      la.valid = 0xfu;
      lb.base = WM;
#pragma unroll
      for (int i = 0; i < 4; ++i) {
        la.off[i] = 32 * i * 1024;
        la.ssq[i] = 0.f;
        lb.off[i] = (nt * 128 + lrow + 32 * i) * 1024;
      }
      gemm_mainloop<1>(la, lb, 16, acc, smem);
      write_rstd(la, smem);
      u16* km = (u16*)(p.ws + OFF_KM);
      u16* vmt = (u16*)(p.ws + OFF_VMT);
      epi_foreach(acc, [&](int row, int col, float v) {
        int key = (mt & 1) * 128 + row, n = nt * 128 + col;
        u16 o = tobf(v * rs[row]);
        if (n < 512) km[((size_t)(seq * 4 + (n >> 7)) * 256 + key) * 128 + (n & 127)] = o;
        else { n -= 512; vmt[((size_t)(seq * 4 + (n >> 7)) * 128 + (n & 127)) * 256 + key] = o; }
      });
    }
    __syncthreads();
  }
}

DI void na_item(const Params& p, int layer, int item, char* smem) {
  const int tid = tidx(), lane = tid & 63, wave = tid >> 6;
  const int r = lane & 31, h = lane >> 5, qt = wave & 1, half = wave >> 1;
  const int grow = item >> 3, head = item & 7;
  int seq, gi, rows;
  if (grow < 512) { seq = grow >> 7; gi = grow & 127; rows = 128; }
  else { seq = 4 + ((grow - 512) >> 5); gi = (grow - 512) & 31; rows = 32; }
  const int s0 = seq_start(seq), L = seq_len(seq);
  int r0 = gi - 4;
  r0 = r0 < 0 ? 0 : (r0 > rows - 8 ? rows - 8 : r0);
  const u16* QN = (const u16*)(p.ws + OFF_QN);
  const u16* KN = (const u16*)(p.ws + OFF_KN);
  const u16* VT = (const u16*)(p.ws + OFF_VTN) + (size_t)s0 * 512;
  float* tb = (float*)(smem + AUX);
  const int ktok0 = s0 + r0 * 64;
#pragma unroll 4
  for (int it = 0; it < 16; ++it) {
    int idx = tid + 256 * it, key = idx >> 3, c = idx & 7;
    uint4 v = *(const uint4*)(KN + (size_t)(ktok0 + key) * 512 + head * 64 + c * 8);
    *(uint4*)(smem + key * 128 + ((c ^ ((key >> 1) & 7)) * 16)) = v;
  }
  if (tid < 248) {
    int wr = tid / 31, co = tid % 31;
    tb[wr * 32 + co] = p.na_rpb[((size_t)(layer * 8 + head) * 15 + (r0 + wr - gi + 7)) * 31 + co];
  }
  const int qtok = s0 + gi * 64 + qt * 32 + r;
  bf16x8 qf[4];
#pragma unroll
  for (int ks = 0; ks < 4; ++ks) qf[ks] = *(const bf16x8*)(QN + (size_t)qtok * 512 + head * 64 + ks * 16 + 8 * h);
  __syncthreads();
  const int qc = qt * 32 + r;
  int c0 = qc - 8;
  c0 = c0 < 0 ? 0 : (c0 > 48 ? 48 : c0);
  const float L2E = 1.4426950408889634f;
  float m = -1e30f;
  typedef __fp16 h2 __attribute__((ext_vector_type(2)));
  uint32_t P[8][8];
#pragma unroll
  for (int kt = 0; kt < 8; ++kt) {
    f32x16 S;
#pragma unroll
    for (int i = 0; i < 16; ++i) S[i] = 0.f;
    const int gt = 8 * half + kt, wr = gt >> 1;
    const int key = 32 * gt + kperm(r);
#pragma unroll
    for (int ks = 0; ks < 4; ++ks) {
      bf16x8 kf = *(const bf16x8*)(smem + key * 128 + (((2 * ks + h) ^ ((key >> 1) & 7)) * 16));
      S = MFMA(kf, qf[ks], S);
    }
    float sv[16];
#pragma unroll
    for (int i = 0; i < 16; ++i) {
      int kc = 32 * (gt & 1) + 16 * (i >> 3) + 8 * h + (i & 7);
      bool valid = (kc >= c0) && (kc < c0 + 16);
      int co = kc - qc + 15;
      co = co < 0 ? 0 : (co > 30 ? 30 : co);
      float x = (S[i] * 0.125f + tb[wr * 32 + co]) * L2E;
      sv[i] = valid ? x : -60000.f;
      m = fmaxf(m, sv[i]);
    }
#pragma unroll
    for (int i = 0; i < 16; i += 2) P[kt][i >> 1] = __builtin_bit_cast(uint32_t, __builtin_amdgcn_cvt_pkrtz(sv[i], sv[i + 1]));
  }
  m = fmaxf(m, __shfl_xor(m, 32));
  float l = 0.f;
#pragma unroll
  for (int kt = 0; kt < 8; ++kt)
#pragma unroll
    for (int j = 0; j < 8; ++j) {
      const h2 hv = __builtin_bit_cast(h2, P[kt][j]);
      const float p0 = __builtin_amdgcn_exp2f((float)hv[0] - m), p1 = __builtin_amdgcn_exp2f((float)hv[1] - m);
      l += p0 + p1;
      P[kt][j] = pack2(p0, p1);
    }
  l += __shfl_xor(l, 32);
  __syncthreads();
#pragma unroll 4
  for (int it = 0; it < 16; ++it) {
    int idx = tid + 256 * it, d = idx >> 6, c = idx & 63;
    uint4 v = *(const uint4*)(VT + (size_t)(head * 64 + d) * L + r0 * 64 + c * 8);
    *(uint4*)(smem + d * 1024 + ((c ^ (d & 15)) * 16)) = v;
  }
  __syncthreads();
  f32x16 O[2];
#pragma unroll
  for (int dt = 0; dt < 2; ++dt)
#pragma unroll
    for (int i = 0; i < 16; ++i) O[dt][i] = 0.f;
#pragma unroll
  for (int kt = 0; kt < 8; ++kt) {
    const int gt = 8 * half + kt;
#pragma unroll
    for (int s = 0; s < 2; ++s) {
      uint4 pk = make_uint4(P[kt][4 * s + 0], P[kt][4 * s + 1], P[kt][4 * s + 2], P[kt][4 * s + 3]);
      bf16x8 pf = __builtin_bit_cast(bf16x8, pk);
#pragma unroll
      for (int dt = 0; dt < 2; ++dt) {
        int d = 32 * dt + r, c = 4 * gt + 2 * s + h;
        bf16x8 vf = *(const bf16x8*)(smem + d * 1024 + ((c ^ (d & 15)) * 16));
        O[dt] = MFMA(vf, pf, O[dt]);
      }
    }
  }
  __syncthreads();
  float* ost = (float*)smem;
  float* mls = (float*)(smem + 16384);
  if (half == 1) {
#pragma unroll
    for (int dt = 0; dt < 2; ++dt)
#pragma unroll
      for (int i = 0; i < 16; ++i) ost[(qt * 32 + dt * 16 + i) * 64 + lane] = O[dt][i];
    mls[(qt * 2 + 0) * 64 + lane] = m;
    mls[(qt * 2 + 1) * 64 + lane] = l;
  }
  __syncthreads();
  if (half == 0) {
    float m2 = mls[(qt * 2 + 0) * 64 + lane], l2 = mls[(qt * 2 + 1) * 64 + lane];
    float mm = fmaxf(m, m2), a1 = __builtin_amdgcn_exp2f(m - mm), a2 = __builtin_amdgcn_exp2f(m2 - mm);
    float inv = 1.f / (l * a1 + l2 * a2);
    a1 *= inv;
    a2 *= inv;
    u16* o = (u16*)(p.ws + OFF_QN) + (size_t)qtok * 512 + head * 64;
#pragma unroll
    for (int dt = 0; dt < 2; ++dt)
#pragma unroll
      for (int g = 0; g < 4; ++g) {
        float v[4];
#pragma unroll
        for (int j = 0; j < 4; ++j) v[j] = O[dt][4 * g + j] * a1 + ost[(qt * 32 + dt * 16 + 4 * g + j) * 64 + lane] * a2;
        *(uint2*)(o + 32 * dt + 8 * g + 4 * h) = make_uint2(pack2(v[0], v[1]), pack2(v[2], v[3]));
      }
  }
  __syncthreads();
}

DI void mem_item(const Params& p, int item, char* smem) {
  const int tid = tidx(), lane = tid & 63, wave = tid >> 6;
  const int r = lane & 31, h = lane >> 5;
  int seq, head, qtile;
  if (item < 1024) { seq = item >> 8; head = (item >> 6) & 3; qtile = item & 63; }
  else { int it2 = item - 1024; seq = 4 + (it2 >> 6); head = (it2 >> 4) & 3; qtile = it2 & 15; }
  const u16* KM = (const u16*)(p.ws + OFF_KM) + (size_t)(seq * 4 + head) * 256 * 128;
  const u16* VM = (const u16*)(p.ws + OFF_VMT) + (size_t)(seq * 4 + head) * 128 * 256;
  u16* QM = (u16*)(p.ws + OFF_QM);
#pragma unroll 4
  for (int it = 0; it < 16; ++it) {
    int idx = tid + 256 * it, key = idx >> 4, c = idx & 15;
    uint4 v = *(const uint4*)(KM + (size_t)key * 128 + c * 8);
    *(uint4*)(smem + key * 256 + ((c ^ (key & 15)) * 16)) = v;
  }
  const int qtok = seq_start(seq) + qtile * 128 + wave * 32 + r;
  bf16x8 qf[8];
#pragma unroll
  for (int ks = 0; ks < 8; ++ks) qf[ks] = *(const bf16x8*)(QM + (size_t)qtok * 512 + head * 128 + ks * 16 + 8 * h);
  __syncthreads();
  const float csc = 0.08838834764831845f * 1.4426950408889634f;
  float m = -1e30f;
#pragma unroll 1
  for (int kt = 0; kt < 8; ++kt) {
    f32x16 S;
#pragma unroll
    for (int i = 0; i < 16; ++i) S[i] = 0.f;
    const int key = 32 * kt + kperm(r);
#pragma unroll
    for (int ks = 0; ks < 8; ++ks) {
      bf16x8 kf = *(const bf16x8*)(smem + key * 256 + (((2 * ks + h) ^ (key & 15)) * 16));
      S = MFMA(kf, qf[ks], S);
    }
#pragma unroll
    for (int i = 0; i < 16; ++i) m = fmaxf(m, S[i]);
  }
  m = fmaxf(m, __shfl_xor(m, 32));
  const float mc = m * csc;
  float l = 0.f;
  uint32_t P[8][8];
#pragma unroll
  for (int kt = 0; kt < 8; ++kt) {
    f32x16 S;
#pragma unroll
    for (int i = 0; i < 16; ++i) S[i] = 0.f;
    const int key = 32 * kt + kperm(r);
#pragma unroll
    for (int ks = 0; ks < 8; ++ks) {
      bf16x8 kf = *(const bf16x8*)(smem + key * 256 + (((2 * ks + h) ^ (key & 15)) * 16));
      S = MFMA(kf, qf[ks], S);
    }
#pragma unroll
    for (int i = 0; i < 16; i += 2) {
      float p0 = __builtin_amdgcn_exp2f(S[i] * csc - mc), p1 = __builtin_amdgcn_exp2f(S[i + 1] * csc - mc);
      l += p0 + p1;
      P[kt][i >> 1] = pack2(p0, p1);
    }
  }
  l += __shfl_xor(l, 32);
  __syncthreads();
#pragma unroll 4
  for (int it = 0; it < 16; ++it) {
    int idx = tid + 256 * it, d = idx >> 5, c = idx & 31;
    uint4 v = *(const uint4*)(VM + (size_t)d * 256 + c * 8);
    *(uint4*)(smem + d * 512 + ((c ^ (d & 15)) * 16)) = v;
  }
  __syncthreads();
  f32x16 O[4];
#pragma unroll
  for (int dt = 0; dt < 4; ++dt)
#pragma unroll
    for (int i = 0; i < 16; ++i) O[dt][i] = 0.f;
#pragma unroll
  for (int kt = 0; kt < 8; ++kt) {
#pragma unroll
    for (int s = 0; s < 2; ++s) {
      uint4 pk = make_uint4(P[kt][4 * s + 0], P[kt][4 * s + 1], P[kt][4 * s + 2], P[kt][4 * s + 3]);
      bf16x8 pf = __builtin_bit_cast(bf16x8, pk);
#pragma unroll
      for (int dt = 0; dt < 4; ++dt) {
        int d = 32 * dt + r, c = 4 * kt + 2 * s + h;
        bf16x8 vf = *(const bf16x8*)(smem + d * 512 + ((c ^ (d & 15)) * 16));
        O[dt] = MFMA(vf, pf, O[dt]);
      }
    }
  }
  const float inv = 1.f / l;
  u16* o = QM + (size_t)qtok * 512 + head * 128;
#pragma unroll
  for (int dt = 0; dt < 4; ++dt)
#pragma unroll
    for (int g = 0; g < 4; ++g)
      *(uint2*)(o + 32 * dt + 8 * g + 4 * h) = make_uint2(pack2(O[dt][4 * g + 0] * inv, O[dt][4 * g + 1] * inv),
                                                         pack2(O[dt][4 * g + 2] * inv, O[dt][4 * g + 3] * inv));
  __syncthreads();
}

typedef __attribute__((ext_vector_type(2))) float f2;
template <int RPT>
DI void scan_item(const Params& p, int layer, int item, int rbase, char* smem) {
  const int tid = tidx(), lane = tid & 63, wave = tid >> 6;
  int seq, head, dir;
  if (item < 64) { seq = item >> 4; head = (item >> 1) & 7; dir = item & 1; }
  else { int it2 = item - 64; seq = 4 + (it2 >> 4); head = (it2 >> 1) & 7; dir = it2 & 1; }
  const int s0 = seq_start(seq), L = seq_len(seq);
  float* sr = (float*)smem;
  float* sw = sr + 1024;
  float* sk = sw + 1024;
  float* sv = sk + 1024;
  float* sa = sv + 1024;
  float* sb = sa + 1024;
  float* swr = sb + 1024;
  float* sbr = swr + 1024;
  float* skr = sbr + 16;
  char* xwb = (char*)(skr + 16);
  char* xab = xwb + 16 * 144;
  const u16* RR = (const u16*)(p.ws + OFF_RR);
  const u16* KR = (const u16*)(p.ws + OFF_KR);
  const u16* VR = (const u16*)(p.ws + OFF_VR);
  const u16* XW = (const u16*)(p.ws + OFF_XW);
  const u16* XA = (const u16*)(p.ws + OFF_XA);
  u16* Y = (u16*)(p.ws + (dir ? OFF_YB : OFF_YF));
  float* BON = (float*)(p.ws + OFF_BON);
  const float* cw = p.rw_conv + (size_t)layer * 3 * RW_COLS;
  const int ts = tid >> 4, part = tid & 15, ch0 = part * 4, gc0 = head * 64 + ch0;
  float cwr[3][4], cwk[3][4], cwv[3][4], cww[3][4], cwa[3][4], kkw[4], rkw[4];
#pragma unroll
  for (int c = 0; c < 4; ++c) {
#pragma unroll
    for (int d = 0; d < 3; ++d) {
      cwr[d][c] = cw[d * RW_COLS + gc0 + c];
      cwk[d][c] = cw[d * RW_COLS + 512 + gc0 + c];
      cwv[d][c] = cw[d * RW_COLS + 1024 + gc0 + c];
      cww[d][c] = cw[d * RW_COLS + 1536 + dir * 64 + ch0 + c];
      cwa[d][c] = cw[d * RW_COLS + 1664 + dir * 64 + ch0 + c];
    }
    kkw[c] = p.rw_k_k[layer * 512 + gc0 + c];
    rkw[c] = p.rw_r_k[layer * 512 + gc0 + c];
  }
  const int mat = wave & 1, ntile = wave >> 1, lr = lane & 31, lh = lane >> 5;
  const int lch = ntile * 32 + lr, lgc = head * 64 + lch;
  bf16x8 wfr[4];
  {
    const float* wsrc = (mat ? p.rw_a2 : p.rw_decay2) + (size_t)(layer * 2 + dir) * 64 * 512 + lgc;
#pragma unroll
    for (int ks = 0; ks < 4; ++ks) {
      float e[8];
#pragma unroll
      for (int j = 0; j < 8; ++j) e[j] = wsrc[(size_t)(ks * 16 + 8 * lh + j) * 512];
      uint4 u = make_uint4(pack2(e[0], e[1]), pack2(e[2], e[3]), pack2(e[4], e[5]), pack2(e[6], e[7]));
      wfr[ks] = __builtin_bit_cast(bf16x8, u);
    }
  }
  const float lbias = (mat ? p.rw_a0 : p.rw_decay0)[(layer * 2 + dir) * 512 + lgc];
  const float lka = p.rw_k_a[layer * 512 + lgc];
  f2 St[RPT][2];
#pragma unroll
  for (int i = 0; i < RPT; ++i) { St[i][0] = (f2)(0.f); St[i][1] = (f2)(0.f); }
  const int rg = tid >> 4, cg_ = tid & 15;
  uint2 pr[3], pk_[3], pv[3], pw[3], pa[3];
  unsigned pmask = 0;
  auto prefetch = [&](int ci) {
    pmask = 0;
    const int t = dir ? (L - 1 - (ci * 16 + ts)) : (ci * 16 + ts);
#pragma unroll
    for (int d = 0; d < 3; ++d) {
      int tt = t + d - 1;
      bool ok = (tt >= 0) && (tt < L);
      size_t tok = (size_t)(s0 + (ok ? tt : t));
      if (ok) pmask |= 1u << d;
      pr[d] = *(const uint2*)(RR + tok * 512 + gc0);
      pk_[d] = *(const uint2*)(KR + tok * 512 + gc0);
      pv[d] = *(const uint2*)(VR + tok * 512 + gc0);
      pw[d] = *(const uint2*)(XW + tok * 128 + dir * 64 + ch0);
      pa[d] = *(const uint2*)(XA + tok * 128 + dir * 64 + ch0);
    }
  };
  prefetch(0);
  const int nchunks = L / 16;
  for (int ci = 0; ci < nchunks; ++ci) {
    const int t = dir ? (L - 1 - (ci * 16 + ts)) : (ci * 16 + ts);
    float rc[4] = {0, 0, 0, 0}, kc[4] = {0, 0, 0, 0}, vc[4] = {0, 0, 0, 0}, xwv[4] = {0, 0, 0, 0}, xav[4] = {0, 0, 0, 0};
#pragma unroll
    for (int d = 0; d < 3; ++d) {
      if (!((pmask >> d) & 1u)) continue;
      rc[0] += bflo(pr[d].x) * cwr[d][0]; rc[1] += bfhi(pr[d].x) * cwr[d][1]; rc[2] += bflo(pr[d].y) * cwr[d][2]; rc[3] += bfhi(pr[d].y) * cwr[d][3];
      kc[0] += bflo(pk_[d].x) * cwk[d][0]; kc[1] += bfhi(pk_[d].x) * cwk[d][1]; kc[2] += bflo(pk_[d].y) * cwk[d][2]; kc[3] += bfhi(pk_[d].y) * cwk[d][3];
      vc[0] += bflo(pv[d].x) * cwv[d][0]; vc[1] += bfhi(pv[d].x) * cwv[d][1]; vc[2] += bflo(pv[d].y) * cwv[d][2]; vc[3] += bfhi(pv[d].y) * cwv[d][3];
      xwv[0] += bflo(pw[d].x) * cww[d][0]; xwv[1] += bfhi(pw[d].x) * cww[d][1]; xwv[2] += bflo(pw[d].y) * cww[d][2]; xwv[3] += bfhi(pw[d].y) * cww[d][3];
      xav[0] += bflo(pa[d].x) * cwa[d][0]; xav[1] += bfhi(pa[d].x) * cwa[d][1]; xav[2] += bflo(pa[d].y) * cwa[d][2]; xav[3] += bfhi(pa[d].y) * cwa[d][3];
    }
    float kkv[4], ss = 0.f;
#pragma unroll
    for (int c = 0; c < 4; ++c) {
      kkv[c] = kc[c] * kkw[c];
      ss += kkv[c] * kkv[c];
    }
    ss = allsum16(ss);
    const float kn = rsqrtf(fmaxf(ss, 1e-24f));
    *(float4*)(sr + ts * 64 + ch0) = make_float4(rc[0], rc[1], rc[2], rc[3]);
    *(float4*)(sk + ts * 64 + ch0) = make_float4(kc[0], kc[1], kc[2], kc[3]);
    *(float4*)(sv + ts * 64 + ch0) = make_float4(vc[0], vc[1], vc[2], vc[3]);
    *(float4*)(sa + ts * 64 + ch0) = make_float4(-kkv[0] * kn, -kkv[1] * kn, -kkv[2] * kn, -kkv[3] * kn);
    *(uint2*)(xwb + ts * 144 + ch0 * 2) = make_uint2(pack2(tanhf_(xwv[0]), tanhf_(xwv[1])), pack2(tanhf_(xwv[2]), tanhf_(xwv[3])));
    *(uint2*)(xab + ts * 144 + ch0 * 2) = make_uint2(pack2(xav[0], xav[1]), pack2(xav[2], xav[3]));
    __syncthreads();
    {
      f32x16 acc;
#pragma unroll
      for (int i = 0; i < 16; ++i) acc[i] = 0.f;
      const char* asrc = (mat ? xab : xwb) + (lr & 15) * 144 + lh * 16;
#pragma unroll
      for (int ks = 0; ks < 4; ++ks) {
        bf16x8 af = *(const bf16x8*)(asrc + ks * 32);
        acc = MFMA(af, wfr[ks], acc);
      }
#pragma unroll
      for (int i = 0; i < 8; ++i) {
        const int tk = (i & 3) + 8 * (i >> 2) + 4 * lh;
        const float lin = lbias + acc[i];
        if (mat == 0) {
          float x = -lin;
          float sp = x > 20.f ? x : (__builtin_amdgcn_logf(1.f + __expf(x)) * 0.6931471805599453f);
          sw[tk * 64 + lch] = __expf(-__expf(-sp - 0.5f));
        } else {
          float a = sigmoidf_(lin);
          float kcv = sk[tk * 64 + lch], kkn = -sa[tk * 64 + lch];
          sk[tk * 64 + lch] = kcv * (1.f + (a - 1.f) * lka);
          sb[tk * 64 + lch] = kkn * a;
        }
      }
    }
    __syncthreads();
    if (ci + 1 < nchunks) prefetch(ci + 1);
    {
      float4 r4 = *(const float4*)(sr + ts * 64 + ch0), w4 = *(const float4*)(sw + ts * 64 + ch0);
      float4 k4 = *(const float4*)(sk + ts * 64 + ch0), b4 = *(const float4*)(sb + ts * 64 + ch0);
      *(float4*)(swr + ts * 64 + ch0) = make_float4(w4.x * r4.x, w4.y * r4.y, w4.z * r4.z, w4.w * r4.w);
      float brp = b4.x * r4.x + b4.y * r4.y + b4.z * r4.z + b4.w * r4.w;
      float krp = k4.x * r4.x + k4.y * r4.y + k4.z * r4.z + k4.w * r4.w;
      float bsum = r4.x * k4.x * rkw[0] + r4.y * k4.y * rkw[1] + r4.z * k4.z * rkw[2] + r4.w * k4.w * rkw[3];
      brp = allsum16(brp);
      krp = allsum16(krp);
      bsum = allsum16(bsum);
      if (part == 0) {
        sbr[ts] = brp;
        skr[ts] = krp;
        if (rbase == 0) BON[((size_t)(s0 + t) * 8 + head) * 2 + dir] = bsum;
      }
    }
    __syncthreads();
    {
      const float* pc = sa + 4 * cg_;
      const float* pv_ = sv + rbase + RPT * rg;
      float4 a4 = *(const float4*)(pc), w4 = *(const float4*)(pc - 3072), b4 = *(const float4*)(pc + 1024);
      float4 k4 = *(const float4*)(pc - 2048), q4 = *(const float4*)(pc + 2048);
      float vv[4];
#pragma unroll
      for (int i = 0; i < RPT; ++i) vv[i] = pv_[i];
      float brs = sbr[0], krs = skr[0];
#pragma unroll
      for (int s = 0; s < 16; ++s) {
        const int sn = s < 15 ? s + 1 : 15;
        const float4 na4 = *(const float4*)(pc + sn * 64), nw4 = *(const float4*)(pc - 3072 + sn * 64);
        const float4 nb4 = *(const float4*)(pc + 1024 + sn * 64), nk4 = *(const float4*)(pc - 2048 + sn * 64);
        const float4 nq4 = *(const float4*)(pc + 2048 + sn * 64);
        float nvv[4];
#pragma unroll
        for (int i = 0; i < RPT; ++i) nvv[i] = pv_[sn * 64 + i];
        const float nbrs = sbr[sn], nkrs = skr[sn];
        const f2 a01 = {a4.x, a4.y}, a23 = {a4.z, a4.w}, w01 = {w4.x, w4.y}, w23 = {w4.z, w4.w};
        const f2 b01 = {b4.x, b4.y}, b23 = {b4.z, b4.w}, k01 = {k4.x, k4.y}, k23 = {k4.z, k4.w};
        const f2 q01 = {q4.x, q4.y}, q23 = {q4.z, q4.w};
        float sai[RPT], ywi[RPT];
#pragma unroll
        for (int i = 0; i < RPT; ++i) {
          f2 ta = St[i][0] * a01 + St[i][1] * a23;
          f2 ty = St[i][0] * q01 + St[i][1] * q23;
          sai[i] = ta.x + ta.y;
          ywi[i] = ty.x + ty.y;
        }
#pragma unroll
        for (int i = 0; i < RPT; ++i) {
          sai[i] = allsum16(sai[i]);
          ywi[i] = allsum16(ywi[i]);
        }
        float yo[RPT];
#pragma unroll
        for (int i = 0; i < RPT; ++i) {
          yo[i] = ywi[i] + sai[i] * brs + vv[i] * krs;
          const f2 sv2 = {sai[i], sai[i]}, vv2 = {vv[i], vv[i]};
          St[i][0] = St[i][0] * w01 + sv2 * b01 + vv2 * k01;
          St[i][1] = St[i][1] * w23 + sv2 * b23 + vv2 * k23;
        }
        if (cg_ == 0) {
          const int tt = dir ? (L - 1 - (ci * 16 + s)) : (ci * 16 + s);
          u16* yp = Y + (size_t)(s0 + tt) * 512 + head * 64 + rbase + RPT * rg;
          if (RPT == 4) *(uint2*)yp = make_uint2(pack2(yo[0], yo[1]), pack2(yo[RPT - 2], yo[RPT - 1]));
          else if (RPT == 2) *(uint32_t*)yp = pack2(yo[0], yo[RPT - 1]);
          else *yp = tobf(yo[0]);
        }
        a4 = na4; w4 = nw4; b4 = nb4; k4 = nk4; q4 = nq4; brs = nbrs; krs = nkrs;
#pragma unroll
        for (int i = 0; i < RPT; ++i) vv[i] = nvv[i];
      }
    }
    __syncthreads();
  }
}

DI void scan_quarter(const Params& p, int layer, int item, int rbase, char* smem) {
  const int tid = tidx(), lane = tid & 63, wave = tid >> 6;
  const int seq = item >> 4, head = (item >> 1) & 7, dir = item & 1;
  const int s0 = seq_start(seq), L = 8192;
  float* SB = (float*)smem;
  char* xwb = smem + 57600;
  char* xab = xwb + 16 * 144;
  float* dummy = (float*)(smem + 62208);
  const u16* RR = (const u16*)(p.ws + OFF_RR);
  const u16* KR = (const u16*)(p.ws + OFF_KR);
  const u16* VR = (const u16*)(p.ws + OFF_VR);
  const u16* XW = (const u16*)(p.ws + OFF_XW);
  const u16* XA = (const u16*)(p.ws + OFF_XA);
  u16* Y = (u16*)(p.ws + (dir ? OFF_YB : OFF_YF));
  float* BON = (float*)(p.ws + OFF_BON);
  const float* cw = p.rw_conv + (size_t)layer * 3 * RW_COLS;
  const int ts = tid >> 4, part = tid & 15, ch0 = part * 4, gc0 = head * 64 + ch0;
  float* cwt = (float*)(smem + 62720);
  for (int idx = tid; idx < 960; idx += 256) {
    const int arr = idx / 192, d = (idx % 192) >> 6, ch = idx & 63;
    const int col = arr < 3 ? arr * 512 + head * 64 + ch : (arr == 3 ? 1536 : 1664) + dir * 64 + ch;
    cwt[idx] = cw[d * RW_COLS + col];
  }
  float kkw[4], rkw[4];
#pragma unroll
  for (int c = 0; c < 4; ++c) {
    kkw[c] = p.rw_k_k[layer * 512 + gc0 + c];
    rkw[c] = p.rw_r_k[layer * 512 + gc0 + c];
  }
  const int mat = __builtin_amdgcn_readfirstlane(wave & 1), ntile = wave >> 1, lr = lane & 31, lh = lane >> 5;
  const int lch = ntile * 32 + lr, lgc = head * 64 + lch;
  bf16x8 wfr[4];
  {
    const float* wsrc = (mat ? p.rw_a2 : p.rw_decay2) + (size_t)(layer * 2 + dir) * 64 * 512 + lgc;
#pragma unroll
    for (int ks = 0; ks < 4; ++ks) {
      float e[8];
#pragma unroll
      for (int j = 0; j < 8; ++j) e[j] = wsrc[(size_t)(ks * 16 + 8 * lh + j) * 512];
      uint4 u = make_uint4(pack2(e[0], e[1]), pack2(e[2], e[3]), pack2(e[4], e[5]), pack2(e[6], e[7]));
      wfr[ks] = __builtin_bit_cast(bf16x8, u);
    }
  }
  const float lbias = (mat ? p.rw_a0 : p.rw_decay0)[(layer * 2 + dir) * 512 + lgc];
  const float lka = p.rw_k_a[layer * 512 + lgc];
  const int rg = tid >> 4, cg_ = tid & 15, row = rbase + rg;
  uint2 pr[3], pk_[3], pv[3], pw[3], pa[3];
  unsigned pmask = 0;
  auto prefetch = [&](int cn) {
    pmask = 0;
    const int t = dir ? (L - 1 - (cn * 16 + ts)) : (cn * 16 + ts);
#pragma unroll
    for (int d = 0; d < 3; ++d) {
      int tt = t + d - 1;
      bool ok = (tt >= 0) && (tt < L);
      size_t tok = (size_t)(s0 + (ok ? tt : t));
      if (ok) pmask |= 1u << d;
      pr[d] = *(const uint2*)(RR + tok * 512 + gc0);
      pk_[d] = *(const uint2*)(KR + tok * 512 + gc0);
      pv[d] = *(const uint2*)(VR + tok * 512 + gc0);
      pw[d] = *(const uint2*)(XW + tok * 128 + dir * 64 + ch0);
      pa[d] = *(const uint2*)(XA + tok * 128 + dir * 64 + ch0);
    }
  };
  auto stage1 = [&](float* S) {
    float rc[4] = {0, 0, 0, 0}, kc[4] = {0, 0, 0, 0}, vc[4] = {0, 0, 0, 0}, xwv[4] = {0, 0, 0, 0}, xav[4] = {0, 0, 0, 0};
#pragma unroll
    for (int d = 0; d < 3; ++d) {
      const bool okd = (pmask >> d) & 1u;
      const uint2 z2 = make_uint2(0u, 0u);
      const uint2 qr = okd ? pr[d] : z2, qk = okd ? pk_[d] : z2, qv = okd ? pv[d] : z2, qw = okd ? pw[d] : z2, qa = okd ? pa[d] : z2;
      const float4 c_r = *(const float4*)(cwt + (0 * 3 + d) * 64 + ch0), c_k = *(const float4*)(cwt + (1 * 3 + d) * 64 + ch0);
      const float4 c_v = *(const float4*)(cwt + (2 * 3 + d) * 64 + ch0), c_w = *(const float4*)(cwt + (3 * 3 + d) * 64 + ch0);
      const float4 c_a = *(const float4*)(cwt + (4 * 3 + d) * 64 + ch0);
      const float r0 = bflo(qr.x), r1 = bfhi(qr.x), r2 = bflo(qr.y), r3 = bfhi(qr.y);
      const float k0 = bflo(qk.x), k1 = bfhi(qk.x), k2 = bflo(qk.y), k3 = bfhi(qk.y);
      const float v0 = bflo(qv.x), v1 = bfhi(qv.x), v2 = bflo(qv.y), v3 = bfhi(qv.y);
      const float w0 = bflo(qw.x), w1 = bfhi(qw.x), w2 = bflo(qw.y), w3 = bfhi(qw.y);
      const float a0 = bflo(qa.x), a1 = bfhi(qa.x), a2 = bflo(qa.y), a3 = bfhi(qa.y);
      rc[0] += r0 * c_r.x; rc[1] += r1 * c_r.y; rc[2] += r2 * c_r.z; rc[3] += r3 * c_r.w;
      kc[0] += k0 * c_k.x; kc[1] += k1 * c_k.y; kc[2] += k2 * c_k.z; kc[3] += k3 * c_k.w;
      vc[0] += v0 * c_v.x; vc[1] += v1 * c_v.y; vc[2] += v2 * c_v.z; vc[3] += v3 * c_v.w;
      xwv[0] += w0 * c_w.x; xwv[1] += w1 * c_w.y; xwv[2] += w2 * c_w.z; xwv[3] += w3 * c_w.w;
      xav[0] += a0 * c_a.x; xav[1] += a1 * c_a.y; xav[2] += a2 * c_a.z; xav[3] += a3 * c_a.w;
    }
    float kkv[4], ss = 0.f;
#pragma unroll
    for (int c = 0; c < 4; ++c) {
      kkv[c] = kc[c] * kkw[c];
      ss += kkv[c] * kkv[c];
    }
    ss = allsum16(ss);
    const float kn = rsqrtf(fmaxf(ss, 1e-24f));
    *(float4*)(S + ts * 64 + ch0) = make_float4(rc[0], rc[1], rc[2], rc[3]);
    *(float4*)(S + 2048 + ts * 64 + ch0) = make_float4(kc[0], kc[1], kc[2], kc[3]);
    *(float4*)(S + 3072 + ts * 64 + ch0) = make_float4(vc[0], vc[1], vc[2], vc[3]);
    *(float4*)(S + 4096 + ts * 64 + ch0) = make_float4(-kkv[0] * kn, -kkv[1] * kn, -kkv[2] * kn, -kkv[3] * kn);
    *(uint2*)(xwb + ts * 144 + ch0 * 2) = make_uint2(pack2(tanhf_(xwv[0]), tanhf_(xwv[1])), pack2(tanhf_(xwv[2]), tanhf_(xwv[3])));
    *(uint2*)(xab + ts * 144 + ch0 * 2) = make_uint2(pack2(xav[0], xav[1]), pack2(xav[2], xav[3]));
  };
  auto stage2_mfma = [&]() {
    f32x16 acc;
#pragma unroll
    for (int i = 0; i < 16; ++i) acc[i] = 0.f;
    const char* asrc = (mat ? xab : xwb) + (lr & 15) * 144 + lh * 16;
#pragma unroll
    for (int ks = 0; ks < 4; ++ks) {
      bf16x8 af = *(const bf16x8*)(asrc + ks * 32);
      acc = MFMA(af, wfr[ks], acc);
    }
    return acc;
  };
  auto stage2_elem = [&](float* S, const f32x16& acc) {
    if (mat == 0) {
#pragma unroll
      for (int i = 0; i < 8; ++i) {
        const int tk = (i & 3) + 8 * (i >> 2) + 4 * lh;
        float x = -(lbias + acc[i]);
        float sp = x > 20.f ? x : (__builtin_amdgcn_logf(1.f + __expf(x)) * 0.6931471805599453f);
        S[1024 + tk * 64 + lch] = __expf(-__expf(-sp - 0.5f));
      }
    } else {
#pragma unroll
      for (int i = 0; i < 8; ++i) {
        const int tk = (i & 3) + 8 * (i >> 2) + 4 * lh;
        float a = sigmoidf_(lbias + acc[i]);
        float kcv = S[2048 + tk * 64 + lch], kkn = -S[4096 + tk * 64 + lch];
        S[2048 + tk * 64 + lch] = kcv * (1.f + (a - 1.f) * lka);
        S[5120 + tk * 64 + lch] = kkn * a;
      }
    }
  };
  auto stage2b = [&](float* S, int cn) {
    const int t = dir ? (L - 1 - (cn * 16 + ts)) : (cn * 16 + ts);
    float4 r4 = *(const float4*)(S + ts * 64 + ch0), w4 = *(const float4*)(S + 1024 + ts * 64 + ch0);
    float4 k4 = *(const float4*)(S + 2048 + ts * 64 + ch0), b4 = *(const float4*)(S + 5120 + ts * 64 + ch0);
    *(float4*)(S + 6144 + ts * 64 + ch0) = make_float4(w4.x * r4.x, w4.y * r4.y, w4.z * r4.z, w4.w * r4.w);
    float brp = b4.x * r4.x + b4.y * r4.y + b4.z * r4.z + b4.w * r4.w;
    float krp = k4.x * r4.x + k4.y * r4.y + k4.z * r4.z + k4.w * r4.w;
    float bsum = r4.x * k4.x * rkw[0] + r4.y * k4.y * rkw[1] + r4.z * k4.z * rkw[2] + r4.w * k4.w * rkw[3];
    brp = allsum16(brp);
    krp = allsum16(krp);
    bsum = allsum16(bsum);
    float* d1 = part == 0 ? S + 7168 + ts : dummy + (tid & 63);
    float* d2 = part == 0 ? S + 7184 + ts : dummy + 64 + (tid & 63);
    *d1 = brp;
    *d2 = krp;
    if (part == 0 && rbase == 0) BON[((size_t)(s0 + t) * 8 + head) * 2 + dir] = bsum;
  };
  f2 St0 = (f2)(0.f), St1 = (f2)(0.f);
  float4 a4, w4, b4, k4, q4;
  float vv, brs, krs, ykeep = 0.f;
  auto loadstep = [&](const float* C, int s) {
    const float* pc = C + 4096 + s * 64 + 4 * cg_;
    a4 = *(const float4*)(pc);
    w4 = *(const float4*)(pc - 3072);
    b4 = *(const float4*)(pc + 1024);
    k4 = *(const float4*)(pc - 2048);
    q4 = *(const float4*)(pc + 2048);
    vv = C[3072 + s * 64 + row];
    brs = C[7168 + s];
    krs = C[7184 + s];
  };
  auto step = [&](const float* C, int s) {
    const float4 ca = a4, cw4 = w4, cb = b4, ck = k4, cq = q4;
    const float cv = vv, cbr = brs, ckr = krs;
    if (s < 15) loadstep(C, s + 1);
    const f2 a01 = {ca.x, ca.y}, a23 = {ca.z, ca.w}, w01 = {cw4.x, cw4.y}, w23 = {cw4.z, cw4.w};
    const f2 b01 = {cb.x, cb.y}, b23 = {cb.z, cb.w}, k01 = {ck.x, ck.y}, k23 = {ck.z, ck.w};
    const f2 q01 = {cq.x, cq.y}, q23 = {cq.z, cq.w};
    f2 ta = St0 * a01 + St1 * a23;
    f2 ty = St0 * q01 + St1 * q23;
    float sai = allsum16(ta.x + ta.y);
    float ywi = allsum16(ty.x + ty.y);
    const float yo = ywi + sai * cbr + cv * ckr;
    const f2 sv2 = {sai, sai}, vv2 = {cv, cv};
    St0 = St0 * w01 + sv2 * b01 + vv2 * k01;
    St1 = St1 * w23 + sv2 * b23 + vv2 * k23;
    ykeep = (cg_ == s) ? yo : ykeep;
  };
  auto store_y = [&](int ci) {
    const int tt = dir ? (L - 1 - (ci * 16 + cg_)) : (ci * 16 + cg_);
    Y[(size_t)(s0 + tt) * 512 + head * 64 + row] = tobf(ykeep);
  };
  const int nchunks = L / 16;
  prefetch(0);
  __syncthreads();
  stage1(SB);
  __syncthreads();
  {
    f32x16 acc = stage2_mfma();
    stage2_elem(SB, acc);
  }
  __syncthreads();
  prefetch(1);
  stage2b(SB, 0);
  __syncthreads();
#pragma unroll 1
  for (int ci = 0; ci + 1 < nchunks; ++ci) {
    const float* C = SB + (ci & 1) * 7200;
    float* N = SB + ((ci + 1) & 1) * 7200;
    loadstep(C, 0);
    stage1(N);
    step(C, 0); step(C, 1); step(C, 2); step(C, 3); step(C, 4);
    __syncthreads();
    {
      f32x16 acc = stage2_mfma();
      step(C, 5); step(C, 6);
      stage2_elem(N, acc);
      step(C, 7); step(C, 8); step(C, 9);
    }
    __syncthreads();
    {
      const int c2 = ci + 2 < nchunks ? ci + 2 : nchunks - 1;
      prefetch(c2);
    }
    step(C, 10);
    stage2b(N, ci + 1);
    step(C, 11); step(C, 12); step(C, 13); step(C, 14); step(C, 15);
    store_y(ci);
    __syncthreads();
  }
  {
    const int ci = nchunks - 1;
    const float* C = SB + (ci & 1) * 7200;
    loadstep(C, 0);
#pragma unroll
    for (int s = 0; s < 16; ++s) step(C, s);
    store_y(ci);
  }
  __syncthreads();
}

DI void phase_post(const Params& p, int layer, char* smem) {
  const int tid = tidx();
  float* on = (float*)smem;
  float* xgs = on + 16 * 512;
  const u16* YF = (const u16*)(p.ws + OFF_YF);
  const u16* YB = (const u16*)(p.ws + OFF_YB);
  const u16* VR = (const u16*)(p.ws + OFF_VR);
  const u16* XG = (const u16*)(p.ws + OFF_XG);
  const float* BON = (const float*)(p.ws + OFF_BON);
  u16* ORW = (u16*)(p.ws + OFF_ORW);
  const float* cw = p.rw_conv + (size_t)layer * 3 * RW_COLS;
  const float* g2 = p.rw_g2 + (size_t)layer * 160 * 512;
  const float* lw = p.rw_lnx_w + layer * 512;
  const float* lb = p.rw_lnx_b + layer * 512;
  float* wt = xgs + 16 * 160;
  for (int idx = tid; idx < 2560; idx += 256) {
    const int a = idx >> 9, c = idx & 511;
    wt[idx] = a < 3 ? cw[a * RW_COLS + 1024 + c] : (a == 3 ? lw[c] : lb[c]);
  }
  float* wx = wt + 2560;
  for (int idx = tid; idx < 480; idx += 256) wx[idx] = cw[(idx / 160) * RW_COLS + 1792 + (idx % 160)];
  __syncthreads();
  for (int item = blockIdx.x; item < T / 16; item += gridDim.x) {
    const int tok0 = item * 16;
    const int seq = tok_seq(tok0), s0 = seq_start(seq), L = seq_len(seq);
    {
      u16 xm[10], x0[10], xp[10];
#pragma unroll
      for (int it = 0; it < 10; ++it) {
        const int idx = tid + 256 * it, s = idx / 160, j = idx - s * 160;
        const int tok = tok0 + s, t = tok - s0;
        const int tokm = t > 0 ? tok - 1 : tok, tokp = t + 1 < L ? tok + 1 : tok;
        xm[it] = XG[(size_t)tokm * 160 + j];
        x0[it] = XG[(size_t)tok * 160 + j];
        xp[it] = XG[(size_t)tokp * 160 + j];
      }
#pragma unroll
      for (int it = 0; it < 10; ++it) {
        const int idx = tid + 256 * it, s = idx / 160, j = idx - s * 160;
        const int t = tok0 + s - s0;
        const float mkm = t > 0 ? 1.f : 0.f, mkp = t + 1 < L ? 1.f : 0.f;
        const float acc = bf1(xm[it]) * mkm * wx[j] + bf1(x0[it]) * wx[160 + j] + bf1(xp[it]) * mkp * wx[320 + j];
        xgs[idx] = sigmoidf_(acc);
      }
    }
    {
      const int s = tid >> 4, part = tid & 15;
      const int tok = tok0 + s, t = tok - s0;
      const int tokm = t > 0 ? tok - 1 : tok, tokp = t + 1 < L ? tok + 1 : tok;
      const float mkm = t > 0 ? 1.f : 0.f, mkp = t + 1 < L ? 1.f : 0.f;
      uint2 uf[8], ub[8], vm[8], v0[8], vp[8];
      float bn[8];
#pragma unroll
      for (int hd = 0; hd < 8; ++hd) {
        const int gc0 = hd * 64 + part * 4;
        uf[hd] = *(const uint2*)(YF + (size_t)tok * 512 + gc0);
        ub[hd] = *(const uint2*)(YB + (size_t)tok * 512 + gc0);
        vm[hd] = *(const uint2*)(VR + (size_t)tokm * 512 + gc0);
        v0[hd] = *(const uint2*)(VR + (size_t)tok * 512 + gc0);
        vp[hd] = *(const uint2*)(VR + (size_t)tokp * 512 + gc0);
        bn[hd] = BON[((size_t)tok * 8 + hd) * 2] + BON[((size_t)tok * 8 + hd) * 2 + 1];
      }
#pragma unroll
      for (int hd = 0; hd < 8; ++hd) {
        const int gc0 = hd * 64 + part * 4;
        float y[4] = {bflo(uf[hd].x) + bflo(ub[hd].x), bfhi(uf[hd].x) + bfhi(ub[hd].x), bflo(uf[hd].y) + bflo(ub[hd].y), bfhi(uf[hd].y) + bfhi(ub[hd].y)};
        float sum = allsum16(y[0] + y[1] + y[2] + y[3]);
        float mu = sum * (1.f / 64.f);
        float q = 0.f;
#pragma unroll
        for (int c = 0; c < 4; ++c) q += (y[c] - mu) * (y[c] - mu);
        q = allsum16(q);
        float rstd = rsqrtf(q * (1.f / 64.f) + GN_EPS);
        const float4 c0 = *(const float4*)(wt + gc0), c1 = *(const float4*)(wt + 512 + gc0), c2 = *(const float4*)(wt + 1024 + gc0);
        const float4 w4 = *(const float4*)(wt + 1536 + gc0), b4 = *(const float4*)(wt + 2048 + gc0);
        float vc[4];
        vc[0] = bflo(vm[hd].x) * mkm * c0.x + bflo(v0[hd].x) * c1.x + bflo(vp[hd].x) * mkp * c2.x;
        vc[1] = bfhi(vm[hd].x) * mkm * c0.y + bfhi(v0[hd].x) * c1.y + bfhi(vp[hd].x) * mkp * c2.y;
        vc[2] = bflo(vm[hd].y) * mkm * c0.z + bflo(v0[hd].y) * c1.z + bflo(vp[hd].y) * mkp * c2.z;
        vc[3] = bfhi(vm[hd].y) * mkm * c0.w + bfhi(v0[hd].y) * c1.w + bfhi(vp[hd].y) * mkp * c2.w;
        const float wv[4] = {w4.x, w4.y, w4.z, w4.w}, bv[4] = {b4.x, b4.y, b4.z, b4.w};
#pragma unroll
        for (int c = 0; c < 4; ++c) on[s * 512 + gc0 + c] = (y[c] - mu) * rstd * wv[c] + bv[c] + bn[hd] * vc[c];
      }
    }
    __syncthreads();
    float ga[16][2];
#pragma unroll
    for (int s = 0; s < 16; ++s) ga[s][0] = ga[s][1] = 0.f;
    float wa[8], wb[8];
#pragma unroll
    for (int e = 0; e < 4; ++e) {
      wa[e] = g2[(size_t)e * 512 + tid];
      wa[4 + e] = g2[(size_t)e * 512 + tid + 256];
    }
#pragma unroll 1
    for (int j = 0; j < 160; j += 8) {
#pragma unroll
      for (int e = 0; e < 4; ++e) {
        wb[e] = g2[(size_t)(j + 4 + e) * 512 + tid];
        wb[4 + e] = g2[(size_t)(j + 4 + e) * 512 + tid + 256];
      }
#pragma unroll
      for (int s = 0; s < 16; ++s) {
        float4 xv = *(const float4*)(xgs + s * 160 + j);
        ga[s][0] += xv.x * wa[0] + xv.y * wa[1] + xv.z * wa[2] + xv.w * wa[3];
        ga[s][1] += xv.x * wa[4] + xv.y * wa[5] + xv.z * wa[6] + xv.w * wa[7];
      }
      if (j + 8 < 160) {
#pragma unroll
        for (int e = 0; e < 4; ++e) {
          wa[e] = g2[(size_t)(j + 8 + e) * 512 + tid];
          wa[4 + e] = g2[(size_t)(j + 8 + e) * 512 + tid + 256];
        }
      }
#pragma unroll
      for (int s = 0; s < 16; ++s) {
        float4 xv = *(const float4*)(xgs + s * 160 + j + 4);
        ga[s][0] += xv.x * wb[0] + xv.y * wb[1] + xv.z * wb[2] + xv.w * wb[3];
        ga[s][1] += xv.x * wb[4] + xv.y * wb[5] + xv.z * wb[6] + xv.w * wb[7];
      }
    }
#pragma unroll
    for (int s = 0; s < 16; ++s) {
      ORW[(size_t)(tok0 + s) * 512 + tid] = tobf(on[s * 512 + tid] * ga[s][0]);
      ORW[(size_t)(tok0 + s) * 512 + tid + 256] = tobf(on[s * 512 + tid + 256] * ga[s][1]);
    }
    __syncthreads();
  }
}

DI void phase_merge(const Params& p, int layer, char* smem) {
  const int tid = tidx(), lrow = tid >> 3;
  const u16* W = (const u16*)(p.ws + OFF_WIN) + (size_t)layer * IN_COLS * 1024;
  const u16* WB = (const u16*)(p.ws + OFF_WBR) + (size_t)layer * 3 * 1024 * 512;
  const float* rs = (const float*)(smem + AUX);
  u16* MG = (u16*)(p.ws + OFF_MERGED);
  for (int id = blockIdx.x; id < 384 * 8; id += gridDim.x) {
    int mt, nt;
    decode_tile(id, 384, 8, mt, nt);
    const int tok0 = mt * 128;
    f32x16 res[2][2];
    zero_acc(res);
#pragma unroll 1
    for (int br = 0; br < 3; ++br) {
      f32x16 acc[2][2];
      zero_acc(acc);
      LoadF32c<32 * 1024> la;
      LoadBFc<32 * 1024> lb;
      la.base = xrow(p, layer, tok0) + (size_t)lrow * 1024;
      lb.base = W + (size_t)(4000 + br * 1024 + nt * 128 + lrow) * 1024;
#pragma unroll
      for (int i = 0; i < 4; ++i) la.ssq[i] = 0.f;
      gemm_mainloop<1>(la, lb, 16, acc, smem);
      if (br == 0) write_rstd(la, smem);
      uint32_t gpk[2][2][8];
      {
        const int lane = tid & 63, wave = tid >> 6, wm = wave & 1, h = lane >> 5;
#pragma unroll
        for (int a = 0; a < 2; ++a)
#pragma unroll
          for (int b = 0; b < 2; ++b)
#pragma unroll
            for (int i = 0; i < 16; i += 2) {
              int row = wm * 64 + a * 32 + (i & 3) + 8 * (i >> 2) + 4 * h;
              gpk[a][b][i >> 1] = pack2a(sigmoidf_(acc[a][b][i] * rs[row]), sigmoidf_(acc[a][b][i + 1] * rs[row + 1]));
            }
      }
      zero_acc(acc);
      LoadBFc<32 * 512> la2, lb2;
      const u16* osrc = (const u16*)(p.ws + (br == 0 ? OFF_QN : (br == 1 ? OFF_ORW : OFF_QM)));
      la2.base = osrc + (size_t)(tok0 + lrow) * 512;
      lb2.base = WB + (size_t)br * 1024 * 512 + (size_t)(nt * 128 + lrow) * 512;
      gemm_mainloop<1>(la2, lb2, 8, acc, smem);
#pragma unroll
      for (int a = 0; a < 2; ++a)
#pragma unroll
        for (int b = 0; b < 2; ++b)
#pragma unroll
          for (int i = 0; i < 16; i += 2) {
            res[a][b][i] += bflo(gpk[a][b][i >> 1]) * acc[a][b][i];
            res[a][b][i + 1] += bfhi(gpk[a][b][i >> 1]) * acc[a][b][i + 1];
          }
    }
    epi_foreach(res, [&](int row, int col, float v) { MG[(size_t)(tok0 + row) * 1024 + nt * 128 + col] = tobfa(v); });
    __syncthreads();
  }
}

DI void phase_outproj(const Params& p, int layer, char* smem) {
  const int tid = tidx(), lrow = tid >> 3;
  const u16* W = (const u16*)(p.ws + OFF_WOUT) + (size_t)layer * 1024 * 1024;
  const u16* MG = (const u16*)(p.ws + OFF_MERGED);
  typedef LoadBFc<32 * 1024> LT;
  gemm_tiles<2, LT, LT>(
      16, blockIdx.x, gridDim.x, 384 * 8,
      [&](int id, LT& la, LT& lb) {
        int mt, nt;
        decode_tile(id, 384, 8, mt, nt);
        la.base = MG + (size_t)(mt * 128 + lrow) * 1024;
        lb.base = W + (size_t)(nt * 128 + lrow) * 1024;
      },
      [&](int id, f32x16 (&acc)[2][2], LT&) {
        int mt, nt;
        decode_tile(id, 384, 8, mt, nt);
        const int tok0 = mt * 128;
        const float* xb = xrow(p, layer, tok0) + nt * 128;
        float* ob = p.out + (size_t)tok0 * 1024 + nt * 128;
        u16* hb = (u16*)(p.ws + OFF_XB) + (size_t)tok0 * 1024 + nt * 128;
        epi_foreach(acc, [&](int row, int col, float v) {
          const float xn = xb[(size_t)row * 1024 + col] + v;
          ob[(size_t)row * 1024 + col] = xn;
          hb[(size_t)row * 1024 + col] = tobf(xn);
        });
      },
      smem);
}

DI void phase_rowstats(const Params& p) {
  const int tid_ = tidx();
  const int lane = tid_ & 63, wave = tid_ >> 6;
  float* RST = (float*)(p.ws + OFF_RST);
  const int rstride = gridDim.x * 4;
  for (int row = blockIdx.x * 4 + wave; row < T; row += 2 * rstride) {
    const int row2 = row + rstride < T ? row + rstride : row;
    const float4* px = (const float4*)(p.out + (size_t)row * 1024);
    const float4* py = (const float4*)(p.out + (size_t)row2 * 1024);
    float4 va[4], vb[4];
#pragma unroll
    for (int i = 0; i < 4; ++i) { va[i] = px[lane + 64 * i]; vb[i] = py[lane + 64 * i]; }
    float ss = 0.f, st = 0.f;
#pragma unroll
    for (int i = 0; i < 4; ++i) {
      ss += va[i].x * va[i].x + va[i].y * va[i].y + va[i].z * va[i].z + va[i].w * va[i].w;
      st += vb[i].x * vb[i].x + vb[i].y * vb[i].y + vb[i].z * vb[i].z + vb[i].w * vb[i].w;
    }
#pragma unroll
    for (int o = 32; o >= 1; o >>= 1) { ss += __shfl_xor(ss, o); st += __shfl_xor(st, o); }
    if (lane == 0) {
      RST[row] = rsqrtf(ss * (1.f / 1024.f) + RMS_EPS);
      RST[row2] = rsqrtf(st * (1.f / 1024.f) + RMS_EPS);
    }
  }
}

DI void phase_up(const Params& p, int layer, char* smem) {
  const int tid = tidx(), lrow = tid >> 3;
  const u16* W = (const u16*)(p.ws + OFF_WUP) + (size_t)layer * 5632 * 1024;
  float* rs = (float*)(smem + AUX);
  const float* RST = (const float*)(p.ws + OFF_RST);
  const float* cw = p.ffn_conv + (size_t)layer * 3 * 5632;
  const float* cb = p.ffn_conv_b + (size_t)layer * 5632;
  u16* ACT = (u16*)(p.ws + OFF_FFACT);
  u16* us = (u16*)(smem + 36864);
  typedef LoadBFv<32 * 1024> LTA;
  auto tile_geom = [&](int id, int& nt, int& s0, int& L, int& tbase) {
    int mt;
    decode_tile(id, 400, 44, mt, nt);
    int seq, ti;
    if (mt < 264) { seq = mt / 66; ti = mt % 66; }
    else { seq = 4 + (mt - 264) / 17; ti = (mt - 264) % 17; }
    s0 = seq_start(seq);
    L = seq_len(seq);
    tbase = ti * 126 - 1;
  };
  typedef LoadBF2c<32 * 1024> LTB;
  gemm_tiles<2, LTA, LTB>(
      16, blockIdx.x, gridDim.x, 400 * 44,
      [&](int id, LTA& la, LTB& lb) {
        int nt, s0, L, tbase;
        tile_geom(id, nt, s0, L, tbase);
        la.base = (const u16*)(p.ws + OFF_XB) + (long)(s0 + tbase + lrow) * 1024;
        la.valid = 0u;
        la.voff = 0;
        lb.base0 = W + (size_t)(nt * 64 + lrow) * 1024;
        lb.base1 = W + (size_t)(2816 + nt * 64 + lrow) * 1024;
#pragma unroll
        for (int i = 0; i < 4; ++i) {
          int t = tbase + lrow + 32 * i;
          if (t >= 0 && t < L) { la.valid |= 1u << i; la.voff = i * 32 * 1024; }
        }
      },
      [&](int id, f32x16 (&acc)[2][2], LTA& la) {
        int nt, s0, L, tbase;
        tile_geom(id, nt, s0, L, tbase);
        const int c8 = (tid & 7) * 8, ch = nt * 64 + c8;
        float wv[3][8], wg[3][8], bv8[8], bg8[8];
#pragma unroll
        for (int d = 0; d < 3; ++d) {
          *(float4*)&wv[d][0] = *(const float4*)(cw + d * 5632 + ch);
          *(float4*)&wv[d][4] = *(const float4*)(cw + d * 5632 + ch + 4);
          *(float4*)&wg[d][0] = *(const float4*)(cw + d * 5632 + 2816 + ch);
          *(float4*)&wg[d][4] = *(const float4*)(cw + d * 5632 + 2816 + ch + 4);
        }
        *(float4*)&bv8[0] = *(const float4*)(cb + ch);
        *(float4*)&bv8[4] = *(const float4*)(cb + ch + 4);
        *(float4*)&bg8[0] = *(const float4*)(cb + 2816 + ch);
        *(float4*)&bg8[4] = *(const float4*)(cb + 2816 + ch + 4);
        if (tid < 128) {
          const int t = tbase + tid;
          rs[tid] = (t >= 0 && t < L) ? RST[s0 + t] : 0.f;
        }
        __syncthreads();
        epi_foreach(acc, [&](int row, int col, float v) { us[row * 136 + col] = tobf(v * rs[row]); });
        __syncthreads();
#pragma unroll 1
        for (int rr = 1 + (tid >> 3); rr <= 126; rr += 32) {
          const int t = tbase + rr;
          if (t < L) {
            float val[8], gt[8];
#pragma unroll
            for (int e = 0; e < 8; ++e) { val[e] = bv8[e]; gt[e] = bg8[e]; }
#pragma unroll
            for (int d = 0; d < 3; ++d) {
              const uint4 uv = *(const uint4*)(us + (rr - 1 + d) * 136 + c8);
              const uint4 ug = *(const uint4*)(us + (rr - 1 + d) * 136 + 64 + c8);
              val[0] += bflo(uv.x) * wv[d][0]; val[1] += bfhi(uv.x) * wv[d][1]; val[2] += bflo(uv.y) * wv[d][2]; val[3] += bfhi(uv.y) * wv[d][3];
              val[4] += bflo(uv.z) * wv[d][4]; val[5] += bfhi(uv.z) * wv[d][5]; val[6] += bflo(uv.w) * wv[d][6]; val[7] += bfhi(uv.w) * wv[d][7];
              gt[0] += bflo(ug.x) * wg[d][0]; gt[1] += bfhi(ug.x) * wg[d][1]; gt[2] += bflo(ug.y) * wg[d][2]; gt[3] += bfhi(ug.y) * wg[d][3];
              gt[4] += bflo(ug.z) * wg[d][4]; gt[5] += bfhi(ug.z) * wg[d][5]; gt[6] += bflo(ug.w) * wg[d][6]; gt[7] += bfhi(ug.w) * wg[d][7];
            }
            float o[8];
#pragma unroll
            for (int e = 0; e < 8; ++e) o[e] = gt[e] * sigmoidf_(gt[e]) * val[e];
            *(uint4*)(ACT + (size_t)(s0 + t) * DFF + ch) = make_uint4(pack2(o[0], o[1]), pack2(o[2], o[3]), pack2(o[4], o[5]), pack2(o[6], o[7]));
          }
        }
        __syncthreads();
      },
      smem);
}

DI void phase_down(const Params& p, int layer, char* smem) {
  const int tid = tidx(), lrow = tid >> 3;
  const u16* W = (const u16*)(p.ws + OFF_WDN) + (size_t)layer * 1024 * DFF;
  const u16* ACT = (const u16*)(p.ws + OFF_FFACT);
  for (int id = blockIdx.x; id < 384 * 8; id += gridDim.x) {
    int mt, nt;
    decode_tile(id, 384, 8, mt, nt);
    const int tok0 = mt * 128;
    f32x16 acc[2][2];
    zero_acc(acc);
    LoadBFc<32 * DFF> la, lb;
    la.base = ACT + (size_t)(tok0 + lrow) * DFF;
    lb.base = W + (size_t)(nt * 128 + lrow) * DFF;
    gemm_mainloop<2>(la, lb, 44, acc, smem);
    epi_foreach(acc, [&](int row, int col, float v) {
      size_t o = (size_t)(tok0 + row) * 1024 + nt * 128 + col;
      p.out[o] += v;
    });
  }
}

DI void phase_final(const Params& p) {
  const int tid_ = tidx(); const int lane = tid_ & 63, wave = tid_ >> 6;
  const int rstride = gridDim.x * 4;
  float4 g[4];
#pragma unroll
  for (int i = 0; i < 4; ++i) g[i] = ((const float4*)p.final_norm)[lane + 64 * i];
  for (int row = blockIdx.x * 4 + wave; row < T; row += 2 * rstride) {
    const int row2 = row + rstride < T ? row + rstride : row;
    float4* px = (float4*)(p.out + (size_t)row * 1024);
    float4* py = (float4*)(p.out + (size_t)row2 * 1024);
    float4 va[4], vb[4];
#pragma unroll
    for (int i = 0; i < 4; ++i) { va[i] = px[lane + 64 * i]; vb[i] = py[lane + 64 * i]; }
    float ss = 0.f, st = 0.f;
#pragma unroll
    for (int i = 0; i < 4; ++i) {
      ss += va[i].x * va[i].x + va[i].y * va[i].y + va[i].z * va[i].z + va[i].w * va[i].w;
      st += vb[i].x * vb[i].x + vb[i].y * vb[i].y + vb[i].z * vb[i].z + vb[i].w * vb[i].w;
    }
#pragma unroll
    for (int o = 32; o >= 1; o >>= 1) { ss += __shfl_xor(ss, o); st += __shfl_xor(st, o); }
    const float ra = rsqrtf(ss * (1.f / 1024.f) + RMS_EPS), rb = rsqrtf(st * (1.f / 1024.f) + RMS_EPS);
#pragma unroll
    for (int i = 0; i < 4; ++i) {
      px[lane + 64 * i] = make_float4(va[i].x * ra * g[i].x, va[i].y * ra * g[i].y, va[i].z * ra * g[i].z, va[i].w * ra * g[i].w);
      py[lane + 64 * i] = make_float4(vb[i].x * rb * g[i].x, vb[i].y * rb * g[i].y, vb[i].z * rb * g[i].z, vb[i].w * rb * g[i].w);
    }
  }
}

constexpr int NPHASE = 20;
DI void run_phase(const Params& p, int ph, char* smem) {
  if (ph == 0) { phase_convert(p, smem); return; }
  if (ph == NPHASE - 1) { phase_final(p); return; }
  const int layer = (ph - 1) / 9, sub = (ph - 1) % 9;
  switch (sub) {
#define PH_ON(k) (!defined(ONLY) || ONLY == (k))
#if !defined(ONLY) || ONLY == 0
    case 0: phase_inproj(p, layer, smem); break;
#endif
#if !defined(ONLY) || ONLY == 1
    case 1:
      for (int it = blockIdx.x; it < 6144; it += gridDim.x) na_item(p, layer, it, smem);
      break;
#endif
#if !defined(ONLY) || ONLY == 2 || ONLY == 12
    case 2: {
      int* cnt = (int*)(p.ws + OFF_CNT) + layer;
      int* sh = (int*)(smem + AUX + 1024);
#if !defined(ONLY) || ONLY == 2
      for (int ci = blockIdx.x; ci < 384; ci += gridDim.x) {
        if (ci < 256) scan_quarter(p, layer, ci >> 2, (ci & 3) * 16, smem);
        else scan_item<4>(p, layer, 64 + (ci - 256), 0, smem);
      }
#endif
      while (true) {
        __syncthreads();
        if (threadIdx.x == 0) *sh = atomicAdd(cnt, 1);
        __syncthreads();
        const int it = *sh;
        if (it >= 1536) break;
#if !defined(ONLY) || ONLY == 12
        mem_item(p, it, smem);
#endif
      }
    } break;
#endif
#if !defined(ONLY) || ONLY == 3
    case 3: phase_post(p, layer, smem); break;
#endif
#if !defined(ONLY) || ONLY == 4
    case 4: phase_merge(p, layer, smem); break;
#endif
#if !defined(ONLY) || ONLY == 5
    case 5: phase_outproj(p, layer, smem); break;
#endif
    case 6: phase_rowstats(p); break;
#if !defined(ONLY) || ONLY == 6
    case 7: phase_up(p, layer, smem); break;
#endif
#if !defined(ONLY) || ONLY == 7
    case 8: phase_down(p, layer, smem); break;
#endif
  }
}

__global__ void __launch_bounds__(256, 2) mega(Params p) {
  extern __shared__ __attribute__((aligned(16))) char smem[];
#if SINGLE_LAUNCH
  cg::grid_group grid = cg::this_grid();
#pragma unroll 1
  for (int ph = p.phase_lo; ph < p.phase_hi; ++ph) {
    run_phase(p, ph, smem);
    if (ph + 1 < p.phase_hi) {
      asm volatile("s_waitcnt vmcnt(0)" ::: "memory");
      __syncthreads();
      grid.sync();
    }
  }
#else
  run_phase(p, p.phase_lo, smem);
#endif
}

extern "C" void kernel_launch(void* const* d_in, const int* in_sizes, int n_in, void* d_out, int out_size, void* d_ws,
                              size_t ws_size, hipStream_t stream) {
  static int grid_blocks = 0;
  if (!grid_blocks) {
    int dev = 0, cus = 0, per_cu = 0;
    hipGetDevice(&dev);
    hipDeviceGetAttribute(&cus, hipDeviceAttributeMultiprocessorCount, dev);
    hipFuncSetAttribute((const void*)mega, hipFuncAttributeMaxDynamicSharedMemorySize, LDS_BYTES);
    hipOccupancyMaxActiveBlocksPerMultiprocessor(&per_cu, (const void*)mega, 256, LDS_BYTES);
    if (per_cu > 2) per_cu = 2;
    if (per_cu < 1) per_cu = 1;
    grid_blocks = cus * per_cu;
  }
  Params p{};
  const float** pf = (const float**)&p;
  for (int i = 0; i < 28; ++i) pf[i] = (const float*)d_in[i];
  p.out = (float*)d_out;
  p.ws = (char*)d_ws;
  hipMemsetAsync((char*)d_ws + OFF_CNT, 0, 256, stream);
#if SINGLE_LAUNCH
  p.phase_lo = 0;
  p.phase_hi = NPHASE;
  void* args[] = {&p};
  hipError_t e = hipLaunchCooperativeKernel((const void*)mega, dim3(grid_blocks), dim3(256), args, LDS_BYTES, stream);
  if (e != hipSuccess) fprintf(stderr, "cooperative launch failed: %s (grid %d)\n", hipGetErrorString(e), grid_blocks);
#else
  for (int ph = 0; ph < NPHASE; ++ph) {
    p.phase_lo = ph;
    p.phase_hi = ph + 1;
    hipLaunchKernelGGL(mega, dim3(grid_blocks), dim3(256), LDS_BYTES, stream, p);
  }
#endif
}
```

```cpp
#include <hip/hip_runtime.h>
#include <hip/hip_cooperative_groups.h>
#include <stdint.h>
#include <stdio.h>
namespace cg = cooperative_groups;

#ifndef SINGLE_LAUNCH
#define SINGLE_LAUNCH 1
#endif

typedef unsigned short u16;
typedef __attribute__((ext_vector_type(8))) short bf16x8;
typedef __attribute__((ext_vector_type(16))) float f32x16;
#define DI __device__ __forceinline__
#define MFMA(a, b, c) __builtin_amdgcn_mfma_f32_32x32x16_bf16((a), (b), (c), 0, 0, 0)

constexpr int TP = 32768, TS = 16384, T = 49152;
constexpr int IN_COLS = 7072, RW_COLS = 1952, DFF = 2816;
constexpr float RMS_EPS = 1e-6f, GN_EPS = 64e-5f;
constexpr int LDS_BYTES = 75776;
constexpr int AUX = 73728;

constexpr size_t UNIT = (size_t)T * 512 * 2;
constexpr size_t OFF_WIN = 0;
constexpr size_t OFF_WBR = OFF_WIN + (size_t)2 * 7072 * 1024 * 2;
constexpr size_t OFF_WOUT = OFF_WBR + (size_t)2 * 3 * 1024 * 512 * 2;
constexpr size_t OFF_WUP = OFF_WOUT + (size_t)2 * 1024 * 1024 * 2;
constexpr size_t OFF_WDN = OFF_WUP + (size_t)2 * 5632 * 1024 * 2;
constexpr size_t OFF_WMKV = OFF_WDN + (size_t)2 * 1024 * 2816 * 2;
constexpr size_t OFF_KM = OFF_WMKV + (size_t)2 * 1024 * 1024 * 2;
constexpr size_t OFF_VMT = OFF_KM + (size_t)12 * 4 * 256 * 128 * 2;
constexpr size_t OFF_BON = OFF_VMT + (size_t)12 * 4 * 256 * 128 * 2;
constexpr size_t OFF_CNT = OFF_BON + (size_t)T * 8 * 2 * 4;
constexpr size_t OFF_RST = OFF_CNT + 1024;
constexpr size_t OFF_ACT0 = (size_t)88 * 1024 * 1024;
static_assert(OFF_RST + (size_t)T * 4 <= OFF_ACT0, "ws map");
constexpr size_t OFF_QN = OFF_ACT0;
constexpr size_t OFF_KN = OFF_ACT0 + UNIT;
constexpr size_t OFF_VTN = OFF_ACT0 + 2 * UNIT;
constexpr size_t OFF_QM = OFF_ACT0 + 3 * UNIT;
constexpr size_t OFF_RR = OFF_ACT0 + 4 * UNIT;
constexpr size_t OFF_KR = OFF_ACT0 + 5 * UNIT;
constexpr size_t OFF_VR = OFF_ACT0 + 6 * UNIT;
constexpr size_t OFF_XW = OFF_ACT0 + 7 * UNIT;
constexpr size_t OFF_XA = OFF_XW + (size_t)T * 128 * 2;
constexpr size_t OFF_XG = OFF_XA + (size_t)T * 128 * 2;
constexpr size_t OFF_END = OFF_XG + (size_t)T * 160 * 2;
static_assert(OFF_END <= (size_t)512 * 1024 * 1024, "ws too big");
constexpr size_t OFF_XB = OFF_ACT0 + 11 * (UNIT / 2);
static_assert(OFF_XB + 2 * UNIT <= OFF_END, "xb");
constexpr size_t OFF_YF = OFF_KN, OFF_YB = OFF_VTN, OFF_ORW = OFF_RR, OFF_MERGED = OFF_KN, OFF_FFACT = OFF_ACT0;

struct Params {
  const float *x_prompt, *x_sample, *mem_prompt, *mem_sample;
  const float *attn_norm, *w_in, *na_rpb, *rw_conv, *rw_decay0, *rw_decay2, *rw_a0, *rw_a2, *rw_g2, *rw_k_k, *rw_k_a,
      *rw_r_k, *rw_lnx_w, *rw_lnx_b, *mem_norm, *w_mem_kv, *w_branch, *w_out, *ffn_norm, *w_up, *ffn_conv, *ffn_conv_b,
      *w_down, *final_norm;
  float* out;
  char* ws;
  int phase_lo, phase_hi;
};

typedef __bf16 bf2_t __attribute__((ext_vector_type(2)));
typedef float f2_t __attribute__((ext_vector_type(2)));
DI uint32_t pack2(float a, float b) {
  f2_t v = {a, b};
  return __builtin_bit_cast(uint32_t, __builtin_convertvector(v, bf2_t));
}
DI uint32_t pack2a(float a, float b) {
  uint32_t r;
  asm("s_nop 0\n\tv_cvt_pk_bf16_f32 %0, %1, %2" : "=v"(r) : "v"(a), "v"(b));
  return r;
}
DI float bflo(uint32_t u) { return __uint_as_float(u << 16); }
DI float bfhi(uint32_t u) { return __uint_as_float(u & 0xffff0000u); }
DI float bf1(u16 h) { return __uint_as_float(((uint32_t)h) << 16); }
DI u16 tobf(float a) { return (u16)(pack2(a, 0.f) & 0xffffu); }
DI u16 tobfa(float a) { return (u16)(pack2a(a, 0.f) & 0xffffu); }
DI int seq_start(int s) { return s < 4 ? s * 8192 : TP + (s - 4) * 2048; }
DI int seq_len(int s) { return s < 4 ? 8192 : 2048; }
DI int tok_seq(int tok) { return tok < TP ? (tok >> 13) : 4 + ((tok - TP) >> 11); }
DI const float* opq(const float* x) { asm volatile("" : "+s"(x)); return x; }
DI const float* xrow(const Params& p, int layer, int tok) {
  const float* a = opq(p.x_prompt);
  const float* b = opq(p.x_sample);
  const float* c = opq(p.out);
  if (layer == 0) return tok < TP ? a + (size_t)tok * 1024 : b + (size_t)(tok - TP) * 1024;
  return c + (size_t)tok * 1024;
}
DI int tidx() { int t = threadIdx.x; asm volatile("" : "+v"(t)); return t; }
DI int kperm(int r) { return (r & 0x13) | ((r & 4) << 1) | ((r & 8) >> 1); }
template <int N>
DI float row_ror(float v) {
  return __int_as_float(__builtin_amdgcn_update_dpp(0, __float_as_int(v), 0x120 + N, 0xf, 0xf, true));
}
DI float allsum16(float v) {
  v += row_ror<8>(v);
  v += row_ror<4>(v);
  v += row_ror<2>(v);
  v += row_ror<1>(v);
  return v;
}
DI float sigmoidf_(float x) { return __builtin_amdgcn_rcpf(1.f + __expf(-x)); }
DI float tanhf_(float x) { return 1.f - 2.f * __builtin_amdgcn_rcpf(__expf(2.f * x) + 1.f); }
DI void decode_tile(int id, int MT, int NT, int& mt, int& nt) {
  const int x = id & 7, j = id >> 3, LM = MT >> 3;
  const int full = 8 * NT, sr = j / full, rem = j - sr * full;
  int R = LM - 8 * sr;
  R = R > 8 ? 8 : R;
  const int ng = NT >> 3, gsz = R * 8;
  int lm8;
  if (rem < ng * gsz) {
    const int g = rem / gsz, r2 = rem - g * gsz;
    lm8 = r2 >> 3;
    nt = g * 8 + (r2 & 7);
  } else {
    const int r2 = rem - ng * gsz, w = NT - ng * 8;
    lm8 = r2 / w;
    nt = ng * 8 + (r2 - lm8 * w);
  }
  mt = (sr * 8 + lm8) * 8 + x;
}

struct F8 { float4 a, b; };
DI float ssq8(const uint4& v) {
  float s = 0.f, t;
  t = bflo(v.x); s += t * t; t = bfhi(v.x); s += t * t; t = bflo(v.y); s += t * t; t = bfhi(v.y); s += t * t;
  t = bflo(v.z); s += t * t; t = bfhi(v.z); s += t * t; t = bflo(v.w); s += t * t; t = bfhi(v.w); s += t * t;
  return s;
}
struct LoadBF {
  typedef uint4 Raw;
  const u16* base;
  int off[4];
  DI Raw load(int k, int i) const { return *(const uint4*)(base + off[i] + k); }
  DI uint4 finish(const Raw& v, int) { return v; }
};
template <int S32>
struct LoadBFc {
  typedef uint4 Raw;
  const u16* base;
  DI Raw load(int k, int i) const { return *(const uint4*)(base + i * S32 + k); }
  DI uint4 finish(const Raw& v, int) { return v; }
};
template <int S32>
struct LoadBF2c {
  typedef uint4 Raw;
  const u16 *base0, *base1;
  DI Raw load(int k, int i) const { return *(const uint4*)((i < 2 ? base0 : base1) + (i & 1) * S32 + k); }
  DI uint4 finish(const Raw& v, int) { return v; }
};
template <int S32>
struct LoadBFv {
  typedef uint4 Raw;
  const u16* base;
  unsigned valid;
  int voff;
  DI Raw load(int k, int i) const { return *(const uint4*)(base + (((valid >> i) & 1u) ? i * S32 : voff) + k); }
  DI uint4 finish(const Raw& v, int i) { return ((valid >> i) & 1u) ? v : make_uint4(0, 0, 0, 0); }
};
template <int S32>
struct LoadBFs {
  typedef uint4 Raw;
  const u16* base;
  unsigned valid;
  float ssq[4];
  DI Raw load(int k, int i) const {
    if (!((valid >> i) & 1u)) return make_uint4(0, 0, 0, 0);
    return *(const uint4*)(base + i * S32 + k);
  }
  DI uint4 finish(const Raw& v, int i) { ssq[i] += ssq8(v); return v; }
};
struct LoadF32 {
  typedef F8 Raw;
  const float* base;
  int off[4];
  unsigned valid;
  float ssq[4];
  DI Raw load(int k, int i) const {
    F8 r;
    if (!((valid >> i) & 1u)) { r.a = make_float4(0, 0, 0, 0); r.b = r.a; return r; }
    const float4* p = (const float4*)(base + off[i] + k);
    r.a = p[0]; r.b = p[1];
    return r;
  }
  DI uint4 finish(const Raw& r, int i) {
    const float4 a = r.a, b = r.b;
    ssq[i] += a.x * a.x + a.y * a.y + a.z * a.z + a.w * a.w + b.x * b.x + b.y * b.y + b.z * b.z + b.w * b.w;
    return make_uint4(pack2(a.x, a.y), pack2(a.z, a.w), pack2(b.x, b.y), pack2(b.z, b.w));
  }
};
template <int S32>
struct LoadF32c {
  typedef F8 Raw;
  const float* base;
  float ssq[4];
  DI Raw load(int k, int i) const {
    F8 r;
    const float4* p = (const float4*)(base + i * S32 + k);
    r.a = p[0]; r.b = p[1];
    return r;
  }
  DI uint4 finish(const Raw& r, int i) {
    const float4 a = r.a, b = r.b;
    ssq[i] += a.x * a.x + a.y * a.y + a.z * a.z + a.w * a.w + b.x * b.x + b.y * b.y + b.z * b.z + b.w * b.w;
    return make_uint4(pack2(a.x, a.y), pack2(a.z, a.w), pack2(b.x, b.y), pack2(b.z, b.w));
  }
};

template <int NPRE, class LA, class LB>
DI void gemm_mainloop(LA& la, LB& lb, int ktiles, f32x16 (&acc)[2][2], char* smem) {
  const int tid = tidx(), lane = tid & 63, wave = tid >> 6;
  const int wm = wave & 1, wn = wave >> 1, r = lane & 31, h = lane >> 5;
  const int lrow = tid >> 3, lkc = tid & 7;
  const int wofs = lrow * 144 + lkc * 16;
  const int aofs = (wm * 64 + r) * 144 + h * 16, bofs = 18432 + (wn * 64 + r) * 144 + h * 16;
  typename LA::Raw ra[NPRE][4];
  typename LB::Raw rb[NPRE][4];
#pragma unroll
  for (int i = 0; i < 4; ++i) {
    ra[0][i] = la.load(lkc * 8, i);
    rb[0][i] = lb.load(lkc * 8, i);
  }
  __syncthreads();
#pragma unroll
  for (int i = 0; i < 4; ++i) {
    *(uint4*)(smem + wofs + i * 4608) = la.finish(ra[0][i], i);
    *(uint4*)(smem + 18432 + wofs + i * 4608) = lb.finish(rb[0][i], i);
  }
#pragma unroll
  for (int pz = 0; pz < NPRE; ++pz) {
    if (pz + 1 < ktiles) {
#pragma unroll
      for (int i = 0; i < 4; ++i) {
        ra[pz][i] = la.load((pz + 1) * 64 + lkc * 8, i);
        rb[pz][i] = lb.load((pz + 1) * 64 + lkc * 8, i);
      }
    }
  }
  __syncthreads();
  for (int kt0 = 0; kt0 < ktiles; kt0 += NPRE) {
#pragma unroll
    for (int u = 0; u < NPRE; ++u) {
      const int kt = kt0 + u;
      char* cur = smem + (kt & 1) * 36864;
      char* nxt = smem + ((kt + 1) & 1) * 36864;
#pragma unroll
      for (int ks = 0; ks < 4; ++ks) {
        bf16x8 af[2], bfr[2];
#pragma unroll
        for (int mt = 0; mt < 2; ++mt) af[mt] = *(const bf16x8*)(cur + aofs + mt * 4608 + ks * 32);
#pragma unroll
        for (int nt = 0; nt < 2; ++nt) bfr[nt] = *(const bf16x8*)(cur + bofs + nt * 4608 + ks * 32);
#pragma unroll
        for (int mt = 0; mt < 2; ++mt)
#pragma unroll
          for (int nt = 0; nt < 2; ++nt) acc[mt][nt] = MFMA(af[mt], bfr[nt], acc[mt][nt]);
      }
      if (kt + 1 < ktiles) {
#pragma unroll
        for (int i = 0; i < 4; ++i) {
          *(uint4*)(nxt + wofs + i * 4608) = la.finish(ra[u][i], i);
          *(uint4*)(nxt + 18432 + wofs + i * 4608) = lb.finish(rb[u][i], i);
        }
        if (kt + 1 + NPRE < ktiles) {
#pragma unroll
          for (int i = 0; i < 4; ++i) {
            ra[u][i] = la.load((kt + 1 + NPRE) * 64 + lkc * 8, i);
            rb[u][i] = lb.load((kt + 1 + NPRE) * 64 + lkc * 8, i);
          }
        }
      }
      __syncthreads();
    }
  }
}

DI void zero_acc(f32x16 (&acc)[2][2]);
template <int NPRE, class LA, class LB, class SetupF, class EpiF>
DI void gemm_tiles(int ktiles, int id0, int stride, int idend, SetupF setup, EpiF epi, char* smem) {
  if (id0 >= idend) return;
  const int tid = tidx(), lane = tid & 63, wave = tid >> 6;
  const int wm = wave & 1, wn = wave >> 1, r = lane & 31, h = lane >> 5;
  const int lrow = tid >> 3, lkc = tid & 7;
  const int wofs = lrow * 144 + lkc * 16;
  const int aofs = (wm * 64 + r) * 144 + h * 16, bofs = 18432 + (wn * 64 + r) * 144 + h * 16;
  LA la, lan;
  LB lb, lbn;
  typename LA::Raw ra[NPRE][4];
  typename LB::Raw rb[NPRE][4];
  setup(id0, la, lb);
#pragma unroll
  for (int i = 0; i < 4; ++i) {
    ra[0][i] = la.load(lkc * 8, i);
    rb[0][i] = lb.load(lkc * 8, i);
  }
  __syncthreads();
#pragma unroll
  for (int i = 0; i < 4; ++i) {
    *(uint4*)(smem + wofs + i * 4608) = la.finish(ra[0][i], i);
    *(uint4*)(smem + 18432 + wofs + i * 4608) = lb.finish(rb[0][i], i);
  }
#pragma unroll
  for (int pz = 0; pz < NPRE; ++pz) {
#pragma unroll
    for (int i = 0; i < 4; ++i) {
      ra[pz][i] = la.load((pz + 1) * 64 + lkc * 8, i);
      rb[pz][i] = lb.load((pz + 1) * 64 + lkc * 8, i);
    }
  }
  __syncthreads();
  for (int id = id0; id < idend; id += stride) {
    const int idn = id + stride;
    const bool has_next = idn < idend;
    if (has_next) setup(idn, lan, lbn);
    f32x16 acc[2][2];
    zero_acc(acc);
    for (int kt0 = 0; kt0 < ktiles; kt0 += NPRE) {
#pragma unroll
      for (int u = 0; u < NPRE; ++u) {
        const int kt = kt0 + u;
        char* cur = smem + (kt & 1) * 36864;
        char* nxt = smem + ((kt + 1) & 1) * 36864;
#pragma unroll
        for (int ks = 0; ks < 4; ++ks) {
          bf16x8 af[2], bfr[2];
#pragma unroll
          for (int mt = 0; mt < 2; ++mt) af[mt] = *(const bf16x8*)(cur + aofs + mt * 4608 + ks * 32);
#pragma unroll
          for (int nt = 0; nt < 2; ++nt) bfr[nt] = *(const bf16x8*)(cur + bofs + nt * 4608 + ks * 32);
#pragma unroll
          for (int mt = 0; mt < 2; ++mt)
#pragma unroll
            for (int nt = 0; nt < 2; ++nt) acc[mt][nt] = MFMA(af[mt], bfr[nt], acc[mt][nt]);
        }
        if (kt + 1 < ktiles) {
#pragma unroll
          for (int i = 0; i < 4; ++i) {
            *(uint4*)(nxt + wofs + i * 4608) = la.finish(ra[u][i], i);
            *(uint4*)(nxt + 18432 + wofs + i * 4608) = lb.finish(rb[u][i], i);
          }
        } else if (has_next) {
#pragma unroll
          for (int i = 0; i < 4; ++i) {
            *(uint4*)(nxt + wofs + i * 4608) = lan.finish(ra[u][i], i);
            *(uint4*)(nxt + 18432 + wofs + i * 4608) = lbn.finish(rb[u][i], i);
          }
        }
        const int q = kt + 1 + NPRE;
        if (q < ktiles) {
#pragma unroll
          for (int i = 0; i < 4; ++i) {
            ra[u][i] = la.load(q * 64 + lkc * 8, i);
            rb[u][i] = lb.load(q * 64 + lkc * 8, i);
          }
        } else if (has_next) {
#pragma unroll
          for (int i = 0; i < 4; ++i) {
            ra[u][i] = lan.load((q - ktiles) * 64 + lkc * 8, i);
            rb[u][i] = lbn.load((q - ktiles) * 64 + lkc * 8, i);
          }
        }
        __syncthreads();
      }
    }
    epi(id, acc, la);
    la = lan;
    lb = lbn;
  }
}

DI void zero_acc(f32x16 (&acc)[2][2]) {
#pragma unroll
  for (int a = 0; a < 2; ++a)
#pragma unroll
    for (int b = 0; b < 2; ++b)
#pragma unroll
      for (int i = 0; i < 16; ++i) acc[a][b][i] = 0.f;
}

template <class LA>
DI void write_rstd(LA& la, char* smem) {
  float* rs = (float*)(smem + AUX);
  const int tid = tidx();
#pragma unroll
  for (int i = 0; i < 4; ++i) {
    float s = la.ssq[i];
    s += __shfl_xor(s, 1);
    s += __shfl_xor(s, 2);
    s += __shfl_xor(s, 4);
    if ((tid & 7) == 0) rs[(tid >> 3) + 32 * i] = rsqrtf(s * (1.f / 1024.f) + RMS_EPS);
  }
  __syncthreads();
}

template <class F>
DI void epi_foreach(const f32x16 (&acc)[2][2], F f) {
  const int tid_ = tidx(); const int lane = tid_ & 63, wave = tid_ >> 6;
  const int wm = wave & 1, wn = wave >> 1, r = lane & 31, h = lane >> 5;
#pragma unroll
  for (int mt = 0; mt < 2; ++mt)
#pragma unroll
    for (int nt = 0; nt < 2; ++nt)
#pragma unroll
      for (int i = 0; i < 16; ++i) {
        int row = wm * 64 + mt * 32 + (i & 3) + 8 * (i >> 2) + 4 * h;
        int col = wn * 64 + nt * 32 + r;
        f(row, col, acc[mt][nt][i]);
      }
}

DI void convert_matrix(const float* src, int ld, int K, int N, const float* gain, u16* dst, char* smem) {
  float* tl = (float*)smem;
  const int tid = tidx();
  const int nk = K / 64, tiles = (N / 32) * nk;
  const int kk = tid >> 3, n4 = (tid & 7) * 4;
  float4 nv[2];
  float ng[2];
  auto issue = [&](int t) {
    const int n0 = (t / nk) * 32, k0 = (t % nk) * 64;
#pragma unroll
    for (int rep = 0; rep < 2; ++rep) {
      const int k = kk + 32 * rep;
      nv[rep] = *(const float4*)(src + (size_t)(k0 + k) * ld + n0 + n4);
      ng[rep] = gain ? gain[k0 + k] : 1.f;
    }
  };
  int t = blockIdx.x;
  if (t < tiles) issue(t);
  for (; t < tiles; t += gridDim.x) {
    const int n0 = (t / nk) * 32, k0 = (t % nk) * 64;
    const float4 v0 = nv[0], v1 = nv[1];
    const float g0 = ng[0], g1 = ng[1];
    if (t + (int)gridDim.x < tiles) issue(t + gridDim.x);
    tl[kk * 33 + n4 + 0] = v0.x * g0;
    tl[kk * 33 + n4 + 1] = v0.y * g0;
    tl[kk * 33 + n4 + 2] = v0.z * g0;
    tl[kk * 33 + n4 + 3] = v0.w * g0;
    tl[(kk + 32) * 33 + n4 + 0] = v1.x * g1;
    tl[(kk + 32) * 33 + n4 + 1] = v1.y * g1;
    tl[(kk + 32) * 33 + n4 + 2] = v1.z * g1;
    tl[(kk + 32) * 33 + n4 + 3] = v1.w * g1;
    __syncthreads();
    const int n = tid >> 3, kc = tid & 7;
    float e[8];
#pragma unroll
    for (int j = 0; j < 8; ++j) e[j] = tl[(kc * 8 + j) * 33 + n];
    *(uint4*)(dst + (size_t)(n0 + n) * K + k0 + kc * 8) =
        make_uint4(pack2(e[0], e[1]), pack2(e[2], e[3]), pack2(e[4], e[5]), pack2(e[6], e[7]));
    __syncthreads();
  }
}

DI void phase_convert(const Params& p, char* smem) {
  for (int l = 0; l < 2; ++l) {
    convert_matrix(p.w_in + (size_t)l * 1024 * IN_COLS, IN_COLS, 1024, IN_COLS, p.attn_norm + l * 1024,
                   (u16*)(p.ws + OFF_WIN) + (size_t)l * IN_COLS * 1024, smem);
    for (int i = 0; i < 3; ++i)
      convert_matrix(p.w_branch + (size_t)(l * 3 + i) * 512 * 1024, 1024, 512, 1024, nullptr,
                     (u16*)(p.ws + OFF_WBR) + (size_t)(l * 3 + i) * 1024 * 512, smem);
    convert_matrix(p.w_out + (size_t)l * 1024 * 1024, 1024, 1024, 1024, nullptr, (u16*)(p.ws + OFF_WOUT) + (size_t)l * 1024 * 1024, smem);
    convert_matrix(p.w_up + (size_t)l * 1024 * 5632, 5632, 1024, 5632, p.ffn_norm + l * 1024,
                   (u16*)(p.ws + OFF_WUP) + (size_t)l * 5632 * 1024, smem);
    convert_matrix(p.w_down + (size_t)l * 2816 * 1024, 1024, 2816, 1024, nullptr, (u16*)(p.ws + OFF_WDN) + (size_t)l * 1024 * 2816, smem);
    convert_matrix(p.w_mem_kv + (size_t)l * 1024 * 1024, 1024, 1024, 1024, p.mem_norm + l * 1024,
                   (u16*)(p.ws + OFF_WMKV) + (size_t)l * 1024 * 1024, smem);
  }
}

DI void phase_inproj(const Params& p, int layer, char* smem) {
  const int tid = tidx(), lane = tid & 63, wave = tid >> 6;
  const int wm = wave & 1, wn = wave >> 1, r = lane & 31, h = lane >> 5;
  const u16* W = (const u16*)(p.ws + OFF_WIN) + (size_t)layer * IN_COLS * 1024;
  const u16* WM = (const u16*)(p.ws + OFF_WMKV) + (size_t)layer * 1024 * 1024;
  const float* rs = (const float*)(smem + AUX);
  const int lrow = tid >> 3;
  constexpr int NMAIN = 384 * 32;
  for (int id = blockIdx.x; id < NMAIN + 192; id += gridDim.x) {
    f32x16 acc[2][2];
    zero_acc(acc);
    if (id < NMAIN) {
      LoadF32c<32 * 1024> la;
      LoadBFc<32 * 1024> lb;
      int mt, nt;
      decode_tile(id, 384, 32, mt, nt);
      const int tok0 = mt * 128;
      const int src0 = nt < 28 ? nt * 128 : 3488 + (nt - 28) * 128;
      const int nvalid = nt == 27 ? 32 : 128;
      la.base = xrow(p, layer, tok0) + (size_t)lrow * 1024;
      lb.base = W + (size_t)(src0 + lrow) * 1024;
#pragma unroll
      for (int i = 0; i < 4; ++i) la.ssq[i] = 0.f;
      gemm_mainloop<1>(la, lb, 16, acc, smem);
      write_rstd(la, smem);
      if (nt >= 8 && nt < 12) {
        const int seq = tok_seq(tok0), L = seq_len(seq), t0 = tok0 - seq_start(seq);
        u16* vt = (u16*)(p.ws + OFF_VTN) + (size_t)seq_start(seq) * 512;
#pragma unroll
        for (int mt2 = 0; mt2 < 2; ++mt2)
#pragma unroll
          for (int nt2 = 0; nt2 < 2; ++nt2)
#pragma unroll
            for (int g = 0; g < 4; ++g) {
              int row = wm * 64 + mt2 * 32 + 8 * g + 4 * h;
              int col = (nt - 8) * 128 + wn * 64 + nt2 * 32 + r;
              float v0 = acc[mt2][nt2][4 * g + 0] * rs[row + 0], v1 = acc[mt2][nt2][4 * g + 1] * rs[row + 1];
              float v2 = acc[mt2][nt2][4 * g + 2] * rs[row + 2], v3 = acc[mt2][nt2][4 * g + 3] * rs[row + 3];
              *(uint2*)(vt + (size_t)col * L + t0 + row) = make_uint2(pack2(v0, v1), pack2(v2, v3));
            }
      } else {
        u16* dst;
        int ld, c0;
        if (nt < 4) { dst = (u16*)(p.ws + OFF_QN); ld = 512; c0 = nt * 128; }
        else if (nt < 8) { dst = (u16*)(p.ws + OFF_KN); ld = 512; c0 = (nt - 4) * 128; }
        else if (nt < 16) { dst = (u16*)(p.ws + OFF_RR); ld = 512; c0 = (nt - 12) * 128; }
        else if (nt < 20) { dst = (u16*)(p.ws + OFF_KR); ld = 512; c0 = (nt - 16) * 128; }
        else if (nt < 24) { dst = (u16*)(p.ws + OFF_VR); ld = 512; c0 = (nt - 20) * 128; }
        else if (nt == 24) { dst = (u16*)(p.ws + OFF_XW); ld = 128; c0 = 0; }
        else if (nt == 25) { dst = (u16*)(p.ws + OFF_XA); ld = 128; c0 = 0; }
        else if (nt < 28) { dst = (u16*)(p.ws + OFF_XG); ld = 160; c0 = (nt - 26) * 128; }
        else { dst = (u16*)(p.ws + OFF_QM); ld = 512; c0 = (nt - 28) * 128; }
        epi_foreach(acc, [&](int row, int col, float v) {
          if (col < nvalid) dst[(size_t)(tok0 + row) * ld + c0 + col] = tobf(v * rs[row]);
        });
      }
    } else {
      LoadF32 la;
      LoadBF lb;
      const int id2 = id - NMAIN, mt = id2 >> 3, nt = id2 & 7;
      const int seq = mt >> 1;
      {
        const int mr0 = mt * 128 + lrow;
        la.base = (mt < 8 ? opq(p.mem_prompt) + (size_t)mr0 * 1024 : opq(p.mem_sample) + (size_t)(mr0 - 1024) * 1024);
      }
      la.valid = 0xfu;
      lb.base = WM;
#pragma unroll
      for (int i = 0; i < 4; ++i) {
        la.off[i] = 32 * i * 1024;
        la.ssq[i] = 0.f;
        lb.off[i] = (nt * 128 + lrow + 32 * i) * 1024;
      }
      gemm_mainloop<1>(la, lb, 16, acc, smem);
      write_rstd(la, smem);
      u16* km = (u16*)(p.ws + OFF_KM);
      u16* vmt = (u16*)(p.ws + OFF_VMT);
      epi_foreach(acc, [&](int row, int col, float v) {
        int key = (mt & 1) * 128 + row, n = nt * 128 + col;
        u16 o = tobf(v * rs[row]);
        if (n < 512) km[((size_t)(seq * 4 + (n >> 7)) * 256 + key) * 128 + (n & 127)] = o;
        else { n -= 512; vmt[((size_t)(seq * 4 + (n >> 7)) * 128 + (n & 127)) * 256 + key] = o; }
      });
    }
    __syncthreads();
  }
}

DI void na_item(const Params& p, int layer, int item, char* smem) {
  const int tid = tidx(), lane = tid & 63, wave = tid >> 6;
  const int r = lane & 31, h = lane >> 5, qt = wave & 1, half = wave >> 1;
  const int grow = item >> 3, head = item & 7;
  int seq, gi, rows;
  if (grow < 512) { seq = grow >> 7; gi = grow & 127; rows = 128; }
  else { seq = 4 + ((grow - 512) >> 5); gi = (grow - 512) & 31; rows = 32; }
  const int s0 = seq_start(seq), L = seq_len(seq);
  int r0 = gi - 4;
  r0 = r0 < 0 ? 0 : (r0 > rows - 8 ? rows - 8 : r0);
  const u16* QN = (const u16*)(p.ws + OFF_QN);
  const u16* KN = (const u16*)(p.ws + OFF_KN);
  const u16* VT = (const u16*)(p.ws + OFF_VTN) + (size_t)s0 * 512;
  float* tb = (float*)(smem + AUX);
  const int ktok0 = s0 + r0 * 64;
#pragma unroll
  for (int it = 0; it < 16; ++it) {
    int idx = tid + 256 * it, key = idx >> 3, c = idx & 7;
    uint4 v = *(const uint4*)(KN + (size_t)(ktok0 + key) * 512 + head * 64 + c * 8);
    *(uint4*)(smem + key * 128 + ((c ^ ((key >> 1) & 7)) * 16)) = v;
  }
  if (tid < 248) {
    int wr = tid / 31, co = tid % 31;
    tb[wr * 32 + co] = p.na_rpb[((size_t)(layer * 8 + head) * 15 + (r0 + wr - gi + 7)) * 31 + co];
  }
  const int qtok = s0 + gi * 64 + qt * 32 + r;
  bf16x8 qf[4];
#pragma unroll
  for (int ks = 0; ks < 4; ++ks) qf[ks] = *(const bf16x8*)(QN + (size_t)qtok * 512 + head * 64 + ks * 16 + 8 * h);
  __syncthreads();
  const int qc = qt * 32 + r;
  int c0 = qc - 8;
  c0 = c0 < 0 ? 0 : (c0 > 48 ? 48 : c0);
  const float L2E = 1.4426950408889634f;
  float m = -1e30f;
  typedef __fp16 h2 __attribute__((ext_vector_type(2)));
  uint32_t P[8][8];
#pragma unroll
  for (int kt = 0; kt < 8; ++kt) {
    f32x16 S;
#pragma unroll
    for (int i = 0; i < 16; ++i) S[i] = 0.f;
    const int gt = 8 * half + kt, wr = gt >> 1;
    const int key = 32 * gt + kperm(r);
#pragma unroll
    for (int ks = 0; ks < 4; ++ks) {
      bf16x8 kf = *(const bf16x8*)(smem + key * 128 + (((2 * ks + h) ^ ((key >> 1) & 7)) * 16));
      S = MFMA(kf, qf[ks], S);
    }
    float sv[16];
#pragma unroll
    for (int i = 0; i < 16; ++i) {
      int kc = 32 * (gt & 1) + 16 * (i >> 3) + 8 * h + (i & 7);
      bool valid = (kc >= c0) && (kc < c0 + 16);
      int co = kc - qc + 15;
      co = co < 0 ? 0 : (co > 30 ? 30 : co);
      float x = (S[i] * 0.125f + tb[wr * 32 + co]) * L2E;
      sv[i] = valid ? x : -60000.f;
      m = fmaxf(m, sv[i]);
    }
#pragma unroll
    for (int i = 0; i < 16; i += 2) P[kt][i >> 1] = __builtin_bit_cast(uint32_t, __builtin_amdgcn_cvt_pkrtz(sv[i], sv[i + 1]));
  }
  m = fmaxf(m, __shfl_xor(m, 32));
  float l = 0.f;
#pragma unroll
  for (int kt = 0; kt < 8; ++kt)
#pragma unroll
    for (int j = 0; j < 8; ++j) {
      const h2 hv = __builtin_bit_cast(h2, P[kt][j]);
      const float p0 = __builtin_amdgcn_exp2f((float)hv[0] - m), p1 = __builtin_amdgcn_exp2f((float)hv[1] - m);
      l += p0 + p1;
      P[kt][j] = pack2(p0, p1);
    }
  l += __shfl_xor(l, 32);
  __syncthreads();
#pragma unroll
  for (int it = 0; it < 16; ++it) {
    int idx = tid + 256 * it, d = idx >> 6, c = idx & 63;
    uint4 v = *(const uint4*)(VT + (size_t)(head * 64 + d) * L + r0 * 64 + c * 8);
    *(uint4*)(smem + d * 1024 + ((c ^ (d & 15)) * 16)) = v;
  }
  __syncthreads();
  f32x16 O[2];
#pragma unroll
  for (int dt = 0; dt < 2; ++dt)
#pragma unroll
    for (int i = 0; i < 16; ++i) O[dt][i] = 0.f;
#pragma unroll
  for (int kt = 0; kt < 8; ++kt) {
    const int gt = 8 * half + kt;
#pragma unroll
    for (int s = 0; s < 2; ++s) {
      uint4 pk = make_uint4(P[kt][4 * s + 0], P[kt][4 * s + 1], P[kt][4 * s + 2], P[kt][4 * s + 3]);
      bf16x8 pf = __builtin_bit_cast(bf16x8, pk);
#pragma unroll
      for (int dt = 0; dt < 2; ++dt) {
        int d = 32 * dt + r, c = 4 * gt + 2 * s + h;
        bf16x8 vf = *(const bf16x8*)(smem + d * 1024 + ((c ^ (d & 15)) * 16));
        O[dt] = MFMA(vf, pf, O[dt]);
      }
    }
  }
  __syncthreads();
  float* ost = (float*)smem;
  float* mls = (float*)(smem + 16384);
  if (half == 1) {
#pragma unroll
    for (int dt = 0; dt < 2; ++dt)
#pragma unroll
      for (int i = 0; i < 16; ++i) ost[(qt * 32 + dt * 16 + i) * 64 + lane] = O[dt][i];
    mls[(qt * 2 + 0) * 64 + lane] = m;
    mls[(qt * 2 + 1) * 64 + lane] = l;
  }
  __syncthreads();
  if (half == 0) {
    float m2 = mls[(qt * 2 + 0) * 64 + lane], l2 = mls[(qt * 2 + 1) * 64 + lane];
    float mm = fmaxf(m, m2), a1 = __builtin_amdgcn_exp2f(m - mm), a2 = __builtin_amdgcn_exp2f(m2 - mm);
    float inv = 1.f / (l * a1 + l2 * a2);
    a1 *= inv;
    a2 *= inv;
    u16* o = (u16*)(p.ws + OFF_QN) + (size_t)qtok * 512 + head * 64;
#pragma unroll
    for (int dt = 0; dt < 2; ++dt)
#pragma unroll
      for (int g = 0; g < 4; ++g) {
        float v[4];
#pragma unroll
        for (int j = 0; j < 4; ++j) v[j] = O[dt][4 * g + j] * a1 + ost[(qt * 32 + dt * 16 + 4 * g + j) * 64 + lane] * a2;
        *(uint2*)(o + 32 * dt + 8 * g + 4 * h) = make_uint2(pack2(v[0], v[1]), pack2(v[2], v[3]));
      }
  }
  __syncthreads();
}

DI void mem_item(const Params& p, int item, char* smem) {
  const int tid = tidx(), lane = tid & 63, wave = tid >> 6;
  const int r = lane & 31, h = lane >> 5;
  int seq, head, qtile;
  if (item < 1024) { seq = item >> 8; head = (item >> 6) & 3; qtile = item & 63; }
  else { int it2 = item - 1024; seq = 4 + (it2 >> 6); head = (it2 >> 4) & 3; qtile = it2 & 15; }
  const u16* KM = (const u16*)(p.ws + OFF_KM) + (size_t)(seq * 4 + head) * 256 * 128;
  const u16* VM = (const u16*)(p.ws + OFF_VMT) + (size_t)(seq * 4 + head) * 128 * 256;
  u16* QM = (u16*)(p.ws + OFF_QM);
#pragma unroll 4
  for (int it = 0; it < 16; ++it) {
    int idx = tid + 256 * it, key = idx >> 4, c = idx & 15;
    uint4 v = *(const uint4*)(KM + (size_t)key * 128 + c * 8);
    *(uint4*)(smem + key * 256 + ((c ^ (key & 15)) * 16)) = v;
  }
  const int qtok = seq_start(seq) + qtile * 128 + wave * 32 + r;
  bf16x8 qf[8];
#pragma unroll
  for (int ks = 0; ks < 8; ++ks) qf[ks] = *(const bf16x8*)(QM + (size_t)qtok * 512 + head * 128 + ks * 16 + 8 * h);
  __syncthreads();
  const float csc = 0.08838834764831845f * 1.4426950408889634f;
  float m = -1e30f;
#pragma unroll 1
  for (int kt = 0; kt < 8; ++kt) {
    f32x16 S;
#pragma unroll
    for (int i = 0; i < 16; ++i) S[i] = 0.f;
    const int key = 32 * kt + kperm(r);
#pragma unroll
    for (int ks = 0; ks < 8; ++ks) {
      bf16x8 kf = *(const bf16x8*)(smem + key * 256 + (((2 * ks + h) ^ (key & 15)) * 16));
      S = MFMA(kf, qf[ks], S);
    }
#pragma unroll
    for (int i = 0; i < 16; ++i) m = fmaxf(m, S[i]);
  }
  m = fmaxf(m, __shfl_xor(m, 32));
  const float mc = m * csc;
  float l = 0.f;
  uint32_t P[8][8];
#pragma unroll
  for (int kt = 0; kt < 8; ++kt) {
    f32x16 S;
#pragma unroll
    for (int i = 0; i < 16; ++i) S[i] = 0.f;
    const int key = 32 * kt + kperm(r);
#pragma unroll
    for (int ks = 0; ks < 8; ++ks) {
      bf16x8 kf = *(const bf16x8*)(smem + key * 256 + (((2 * ks + h) ^ (key & 15)) * 16));
      S = MFMA(kf, qf[ks], S);
    }
#pragma unroll
    for (int i = 0; i < 16; i += 2) {
      float p0 = __builtin_amdgcn_exp2f(S[i] * csc - mc), p1 = __builtin_amdgcn_exp2f(S[i + 1] * csc - mc);
      l += p0 + p1;
      P[kt][i >> 1] = pack2(p0, p1);
    }
  }
  l += __shfl_xor(l, 32);
  __syncthreads();
#pragma unroll 4
  for (int it = 0; it < 16; ++it) {
    int idx = tid + 256 * it, d = idx >> 5, c = idx & 31;
    uint4 v = *(const uint4*)(VM + (size_t)d * 256 + c * 8);
    *(uint4*)(smem + d * 512 + ((c ^ (d & 15)) * 16)) = v;
  }
  __syncthreads();
  f32x16 O[4];
#pragma unroll
  for (int dt = 0; dt < 4; ++dt)
#pragma unroll
    for (int i = 0; i < 16; ++i) O[dt][i] = 0.f;
#pragma unroll
  for (int kt = 0; kt < 8; ++kt) {
#pragma unroll
    for (int s = 0; s < 2; ++s) {
      uint4 pk = make_uint4(P[kt][4 * s + 0], P[kt][4 * s + 1], P[kt][4 * s + 2], P[kt][4 * s + 3]);
      bf16x8 pf = __builtin_bit_cast(bf16x8, pk);
#pragma unroll
      for (int dt = 0; dt < 4; ++dt) {
        int d = 32 * dt + r, c = 4 * kt + 2 * s + h;
        bf16x8 vf = *(const bf16x8*)(smem + d * 512 + ((c ^ (d & 15)) * 16));
        O[dt] = MFMA(vf, pf, O[dt]);
      }
    }
  }
  const float inv = 1.f / l;
  u16* o = QM + (size_t)qtok * 512 + head * 128;
#pragma unroll
  for (int dt = 0; dt < 4; ++dt)
#pragma unroll
    for (int g = 0; g < 4; ++g)
      *(uint2*)(o + 32 * dt + 8 * g + 4 * h) = make_uint2(pack2(O[dt][4 * g + 0] * inv, O[dt][4 * g + 1] * inv),
                                                         pack2(O[dt][4 * g + 2] * inv, O[dt][4 * g + 3] * inv));
  __syncthreads();
}

typedef __attribute__((ext_vector_type(2))) float f2;
template <int RPT>
DI void scan_item(const Params& p, int layer, int item, int rbase, char* smem) {
  const int tid = tidx(), lane = tid & 63, wave = tid >> 6;
  int seq, head, dir;
  if (item < 64) { seq = item >> 4; head = (item >> 1) & 7; dir = item & 1; }
  else { int it2 = item - 64; seq = 4 + (it2 >> 4); head = (it2 >> 1) & 7; dir = it2 & 1; }
  const int s0 = seq_start(seq), L = seq_len(seq);
  float* sr = (float*)smem;
  float* sw = sr + 1024;
  float* sk = sw + 1024;
  float* sv = sk + 1024;
  float* sa = sv + 1024;
  float* sb = sa + 1024;
  float* swr = sb + 1024;
  float* sbr = swr + 1024;
  float* skr = sbr + 16;
  char* xwb = (char*)(skr + 16);
  char* xab = xwb + 16 * 144;
  const u16* RR = (const u16*)(p.ws + OFF_RR);
  const u16* KR = (const u16*)(p.ws + OFF_KR);
  const u16* VR = (const u16*)(p.ws + OFF_VR);
  const u16* XW = (const u16*)(p.ws + OFF_XW);
  const u16* XA = (const u16*)(p.ws + OFF_XA);
  u16* Y = (u16*)(p.ws + (dir ? OFF_YB : OFF_YF));
  float* BON = (float*)(p.ws + OFF_BON);
  const float* cw = p.rw_conv + (size_t)layer * 3 * RW_COLS;
  const int ts = tid >> 4, part = tid & 15, ch0 = part * 4, gc0 = head * 64 + ch0;
  float cwr[3][4], cwk[3][4], cwv[3][4], cww[3][4], cwa[3][4], kkw[4], rkw[4];
#pragma unroll
  for (int c = 0; c < 4; ++c) {
#pragma unroll
    for (int d = 0; d < 3; ++d) {
      cwr[d][c] = cw[d * RW_COLS + gc0 + c];
      cwk[d][c] = cw[d * RW_COLS + 512 + gc0 + c];
      cwv[d][c] = cw[d * RW_COLS + 1024 + gc0 + c];
      cww[d][c] = cw[d * RW_COLS + 1536 + dir * 64 + ch0 + c];
      cwa[d][c] = cw[d * RW_COLS + 1664 + dir * 64 + ch0 + c];
    }
    kkw[c] = p.rw_k_k[layer * 512 + gc0 + c];
    rkw[c] = p.rw_r_k[layer * 512 + gc0 + c];
  }
  const int mat = wave & 1, ntile = wave >> 1, lr = lane & 31, lh = lane >> 5;
  const int lch = ntile * 32 + lr, lgc = head * 64 + lch;
  bf16x8 wfr[4];
  {
    const float* wsrc = (mat ? p.rw_a2 : p.rw_decay2) + (size_t)(layer * 2 + dir) * 64 * 512 + lgc;
#pragma unroll
    for (int ks = 0; ks < 4; ++ks) {
      float e[8];
#pragma unroll
      for (int j = 0; j < 8; ++j) e[j] = wsrc[(size_t)(ks * 16 + 8 * lh + j) * 512];
      uint4 u = make_uint4(pack2(e[0], e[1]), pack2(e[2], e[3]), pack2(e[4], e[5]), pack2(e[6], e[7]));
      wfr[ks] = __builtin_bit_cast(bf16x8, u);
    }
  }
  const float lbias = (mat ? p.rw_a0 : p.rw_decay0)[(layer * 2 + dir) * 512 + lgc];
  const float lka = p.rw_k_a[layer * 512 + lgc];
  f2 St[RPT][2];
#pragma unroll
  for (int i = 0; i < RPT; ++i) { St[i][0] = (f2)(0.f); St[i][1] = (f2)(0.f); }
  const int rg = tid >> 4, cg_ = tid & 15;
  uint2 pr[3], pk_[3], pv[3], pw[3], pa[3];
  unsigned pmask = 0;
  auto prefetch = [&](int ci) {
    pmask = 0;
    const int t = dir ? (L - 1 - (ci * 16 + ts)) : (ci * 16 + ts);
#pragma unroll
    for (int d = 0; d < 3; ++d) {
      int tt = t + d - 1;
      bool ok = (tt >= 0) && (tt < L);
      size_t tok = (size_t)(s0 + (ok ? tt : t));
      if (ok) pmask |= 1u << d;
      pr[d] = *(const uint2*)(RR + tok * 512 + gc0);
      pk_[d] = *(const uint2*)(KR + tok * 512 + gc0);
      pv[d] = *(const uint2*)(VR + tok * 512 + gc0);
      pw[d] = *(const uint2*)(XW + tok * 128 + dir * 64 + ch0);
      pa[d] = *(const uint2*)(XA + tok * 128 + dir * 64 + ch0);
    }
  };
  prefetch(0);
  const int nchunks = L / 16;
  for (int ci = 0; ci < nchunks; ++ci) {
    const int t = dir ? (L - 1 - (ci * 16 + ts)) : (ci * 16 + ts);
    float rc[4] = {0, 0, 0, 0}, kc[4] = {0, 0, 0, 0}, vc[4] = {0, 0, 0, 0}, xwv[4] = {0, 0, 0, 0}, xav[4] = {0, 0, 0, 0};
#pragma unroll
    for (int d = 0; d < 3; ++d) {
      if (!((pmask >> d) & 1u)) continue;
      rc[0] += bflo(pr[d].x) * cwr[d][0]; rc[1] += bfhi(pr[d].x) * cwr[d][1]; rc[2] += bflo(pr[d].y) * cwr[d][2]; rc[3] += bfhi(pr[d].y) * cwr[d][3];
      kc[0] += bflo(pk_[d].x) * cwk[d][0]; kc[1] += bfhi(pk_[d].x) * cwk[d][1]; kc[2] += bflo(pk_[d].y) * cwk[d][2]; kc[3] += bfhi(pk_[d].y) * cwk[d][3];
      vc[0] += bflo(pv[d].x) * cwv[d][0]; vc[1] += bfhi(pv[d].x) * cwv[d][1]; vc[2] += bflo(pv[d].y) * cwv[d][2]; vc[3] += bfhi(pv[d].y) * cwv[d][3];
      xwv[0] += bflo(pw[d].x) * cww[d][0]; xwv[1] += bfhi(pw[d].x) * cww[d][1]; xwv[2] += bflo(pw[d].y) * cww[d][2]; xwv[3] += bfhi(pw[d].y) * cww[d][3];
      xav[0] += bflo(pa[d].x) * cwa[d][0]; xav[1] += bfhi(pa[d].x) * cwa[d][1]; xav[2] += bflo(pa[d].y) * cwa[d][2]; xav[3] += bfhi(pa[d].y) * cwa[d][3];
    }
    float kkv[4], ss = 0.f;
#pragma unroll
    for (int c = 0; c < 4; ++c) {
      kkv[c] = kc[c] * kkw[c];
      ss += kkv[c] * kkv[c];
    }
    ss = allsum16(ss);
    const float kn = rsqrtf(fmaxf(ss, 1e-24f));
    *(float4*)(sr + ts * 64 + ch0) = make_float4(rc[0], rc[1], rc[2], rc[3]);
    *(float4*)(sk + ts * 64 + ch0) = make_float4(kc[0], kc[1], kc[2], kc[3]);
    *(float4*)(sv + ts * 64 + ch0) = make_float4(vc[0], vc[1], vc[2], vc[3]);
    *(float4*)(sa + ts * 64 + ch0) = make_float4(-kkv[0] * kn, -kkv[1] * kn, -kkv[2] * kn, -kkv[3] * kn);
    *(uint2*)(xwb + ts * 144 + ch0 * 2) = make_uint2(pack2(tanhf_(xwv[0]), tanhf_(xwv[1])), pack2(tanhf_(xwv[2]), tanhf_(xwv[3])));
    *(uint2*)(xab + ts * 144 + ch0 * 2) = make_uint2(pack2(xav[0], xav[1]), pack2(xav[2], xav[3]));
    __syncthreads();
    {
      f32x16 acc;
#pragma unroll
      for (int i = 0; i < 16; ++i) acc[i] = 0.f;
      const char* asrc = (mat ? xab : xwb) + (lr & 15) * 144 + lh * 16;
#pragma unroll
      for (int ks = 0; ks < 4; ++ks) {
        bf16x8 af = *(const bf16x8*)(asrc + ks * 32);
        acc = MFMA(af, wfr[ks], acc);
      }
#pragma unroll
      for (int i = 0; i < 8; ++i) {
        const int tk = (i & 3) + 8 * (i >> 2) + 4 * lh;
        const float lin = lbias + acc[i];
        if (mat == 0) {
          float x = -lin;
          float sp = x > 20.f ? x : (__builtin_amdgcn_logf(1.f + __expf(x)) * 0.6931471805599453f);
          sw[tk * 64 + lch] = __expf(-__expf(-sp - 0.5f));
        } else {
          float a = sigmoidf_(lin);
          float kcv = sk[tk * 64 + lch], kkn = -sa[tk * 64 + lch];
          sk[tk * 64 + lch] = kcv * (1.f + (a - 1.f) * lka);
          sb[tk * 64 + lch] = kkn * a;
        }
      }
    }
    __syncthreads();
    if (ci + 1 < nchunks) prefetch(ci + 1);
    {
      float4 r4 = *(const float4*)(sr + ts * 64 + ch0), w4 = *(const float4*)(sw + ts * 64 + ch0);
      float4 k4 = *(const float4*)(sk + ts * 64 + ch0), b4 = *(const float4*)(sb + ts * 64 + ch0);
      *(float4*)(swr + ts * 64 + ch0) = make_float4(w4.x * r4.x, w4.y * r4.y, w4.z * r4.z, w4.w * r4.w);
      float brp = b4.x * r4.x + b4.y * r4.y + b4.z * r4.z + b4.w * r4.w;
      float krp = k4.x * r4.x + k4.y * r4.y + k4.z * r4.z + k4.w * r4.w;
      float bsum = r4.x * k4.x * rkw[0] + r4.y * k4.y * rkw[1] + r4.z * k4.z * rkw[2] + r4.w * k4.w * rkw[3];
      brp = allsum16(brp);
      krp = allsum16(krp);
      bsum = allsum16(bsum);
      if (part == 0) {
        sbr[ts] = brp;
        skr[ts] = krp;
        if (rbase == 0) BON[((size_t)(s0 + t) * 8 + head) * 2 + dir] = bsum;
      }
    }
    __syncthreads();
    {
      const float* pc = sa + 4 * cg_;
      const float* pv_ = sv + rbase + RPT * rg;
      float4 a4 = *(const float4*)(pc), w4 = *(const float4*)(pc - 3072), b4 = *(const float4*)(pc + 1024);
      float4 k4 = *(const float4*)(pc - 2048), q4 = *(const float4*)(pc + 2048);
      float vv[4];
#pragma unroll
      for (int i = 0; i < RPT; ++i) vv[i] = pv_[i];
      float brs = sbr[0], krs = skr[0];
#pragma unroll
      for (int s = 0; s < 16; ++s) {
        const int sn = s < 15 ? s + 1 : 15;
        const float4 na4 = *(const float4*)(pc + sn * 64), nw4 = *(const float4*)(pc - 3072 + sn * 64);
        const float4 nb4 = *(const float4*)(pc + 1024 + sn * 64), nk4 = *(const float4*)(pc - 2048 + sn * 64);
        const float4 nq4 = *(const float4*)(pc + 2048 + sn * 64);
        float nvv[4];
#pragma unroll
        for (int i = 0; i < RPT; ++i) nvv[i] = pv_[sn * 64 + i];
        const float nbrs = sbr[sn], nkrs = skr[sn];
        const f2 a01 = {a4.x, a4.y}, a23 = {a4.z, a4.w}, w01 = {w4.x, w4.y}, w23 = {w4.z, w4.w};
        const f2 b01 = {b4.x, b4.y}, b23 = {b4.z, b4.w}, k01 = {k4.x, k4.y}, k23 = {k4.z, k4.w};
        const f2 q01 = {q4.x, q4.y}, q23 = {q4.z, q4.w};
        float sai[RPT], ywi[RPT];
#pragma unroll
        for (int i = 0; i < RPT; ++i) {
          f2 ta = St[i][0] * a01 + St[i][1] * a23;
          f2 ty = St[i][0] * q01 + St[i][1] * q23;
          sai[i] = ta.x + ta.y;
          ywi[i] = ty.x + ty.y;
        }
#pragma unroll
        for (int i = 0; i < RPT; ++i) {
          sai[i] = allsum16(sai[i]);
          ywi[i] = allsum16(ywi[i]);
        }
        float yo[RPT];
#pragma unroll
        for (int i = 0; i < RPT; ++i) {
          yo[i] = ywi[i] + sai[i] * brs + vv[i] * krs;
          const f2 sv2 = {sai[i], sai[i]}, vv2 = {vv[i], vv[i]};
          St[i][0] = St[i][0] * w01 + sv2 * b01 + vv2 * k01;
          St[i][1] = St[i][1] * w23 + sv2 * b23 + vv2 * k23;
        }
        if (cg_ == 0) {
          const int tt = dir ? (L - 1 - (ci * 16 + s)) : (ci * 16 + s);
          u16* yp = Y + (size_t)(s0 + tt) * 512 + head * 64 + rbase + RPT * rg;
          if (RPT == 4) *(uint2*)yp = make_uint2(pack2(yo[0], yo[1]), pack2(yo[RPT - 2], yo[RPT - 1]));
          else if (RPT == 2) *(uint32_t*)yp = pack2(yo[0], yo[RPT - 1]);
          else *yp = tobf(yo[0]);
        }
        a4 = na4; w4 = nw4; b4 = nb4; k4 = nk4; q4 = nq4; brs = nbrs; krs = nkrs;
#pragma unroll
        for (int i = 0; i < RPT; ++i) vv[i] = nvv[i];
      }
    }
    __syncthreads();
  }
}

DI void scan_quarter(const Params& p, int layer, int item, int rbase, char* smem) {
  const int tid = tidx(), lane = tid & 63, wave = tid >> 6;
  const int seq = item >> 4, head = (item >> 1) & 7, dir = item & 1;
  const int s0 = seq_start(seq), L = 8192;
  float* SB = (float*)smem;
  char* xwb = smem + 57600;
  char* xab = xwb + 16 * 144;
  float* dummy = (float*)(smem + 62208);
  const u16* RR = (const u16*)(p.ws + OFF_RR);
  const u16* KR = (const u16*)(p.ws + OFF_KR);
  const u16* VR = (const u16*)(p.ws + OFF_VR);
  const u16* XW = (const u16*)(p.ws + OFF_XW);
  const u16* XA = (const u16*)(p.ws + OFF_XA);
  u16* Y = (u16*)(p.ws + (dir ? OFF_YB : OFF_YF));
  float* BON = (float*)(p.ws + OFF_BON);
  const float* cw = p.rw_conv + (size_t)layer * 3 * RW_COLS;
  const int ts = tid >> 4, part = tid & 15, ch0 = part * 4, gc0 = head * 64 + ch0;
  float* cwt = (float*)(smem + 62720);
  for (int idx = tid; idx < 960; idx += 256) {
    const int arr = idx / 192, d = (idx % 192) >> 6, ch = idx & 63;
    const int col = arr < 3 ? arr * 512 + head * 64 + ch : (arr == 3 ? 1536 : 1664) + dir * 64 + ch;
    cwt[idx] = cw[d * RW_COLS + col];
  }
  float kkw[4], rkw[4];
#pragma unroll
  for (int c = 0; c < 4; ++c) {
    kkw[c] = p.rw_k_k[layer * 512 + gc0 + c];
    rkw[c] = p.rw_r_k[layer * 512 + gc0 + c];
  }
  const int mat = __builtin_amdgcn_readfirstlane(wave & 1), ntile = wave >> 1, lr = lane & 31, lh = lane >> 5;
  const int lch = ntile * 32 + lr, lgc = head * 64 + lch;
  bf16x8 wfr[4];
  {
    const float* wsrc = (mat ? p.rw_a2 : p.rw_decay2) + (size_t)(layer * 2 + dir) * 64 * 512 + lgc;
#pragma unroll
    for (int ks = 0; ks < 4; ++ks) {
      float e[8];
#pragma unroll
      for (int j = 0; j < 8; ++j) e[j] = wsrc[(size_t)(ks * 16 + 8 * lh + j) * 512];
      uint4 u = make_uint4(pack2(e[0], e[1]), pack2(e[2], e[3]), pack2(e[4], e[5]), pack2(e[6], e[7]));
      wfr[ks] = __builtin_bit_cast(bf16x8, u);
    }
  }
  const float lbias = (mat ? p.rw_a0 : p.rw_decay0)[(layer * 2 + dir) * 512 + lgc];
  const float lka = p.rw_k_a[layer * 512 + lgc];
  const int rg = tid >> 4, cg_ = tid & 15, row = rbase + rg;
  uint2 pr[3], pk_[3], pv[3], pw[3], pa[3];
  unsigned pmask = 0;
  auto prefetch = [&](int cn) {
    pmask = 0;
    const int t = dir ? (L - 1 - (cn * 16 + ts)) : (cn * 16 + ts);
#pragma unroll
    for (int d = 0; d < 3; ++d) {
      int tt = t + d - 1;
      bool ok = (tt >= 0) && (tt < L);
      size_t tok = (size_t)(s0 + (ok ? tt : t));
      if (ok) pmask |= 1u << d;
      pr[d] = *(const uint2*)(RR + tok * 512 + gc0);
      pk_[d] = *(const uint2*)(KR + tok * 512 + gc0);
      pv[d] = *(const uint2*)(VR + tok * 512 + gc0);
      pw[d] = *(const uint2*)(XW + tok * 128 + dir * 64 + ch0);
      pa[d] = *(const uint2*)(XA + tok * 128 + dir * 64 + ch0);
    }
  };
  auto stage1 = [&](float* S) {
    float rc[4] = {0, 0, 0, 0}, kc[4] = {0, 0, 0, 0}, vc[4] = {0, 0, 0, 0}, xwv[4] = {0, 0, 0, 0}, xav[4] = {0, 0, 0, 0};
#pragma unroll
    for (int d = 0; d < 3; ++d) {
      const bool okd = (pmask >> d) & 1u;
      const uint2 z2 = make_uint2(0u, 0u);
      const uint2 qr = okd ? pr[d] : z2, qk = okd ? pk_[d] : z2, qv = okd ? pv[d] : z2, qw = okd ? pw[d] : z2, qa = okd ? pa[d] : z2;
      const float4 c_r = *(const float4*)(cwt + (0 * 3 + d) * 64 + ch0), c_k = *(const float4*)(cwt + (1 * 3 + d) * 64 + ch0);
      const float4 c_v = *(const float4*)(cwt + (2 * 3 + d) * 64 + ch0), c_w = *(const float4*)(cwt + (3 * 3 + d) * 64 + ch0);
      const float4 c_a = *(const float4*)(cwt + (4 * 3 + d) * 64 + ch0);
      const float r0 = bflo(qr.x), r1 = bfhi(qr.x), r2 = bflo(qr.y), r3 = bfhi(qr.y);
      const float k0 = bflo(qk.x), k1 = bfhi(qk.x), k2 = bflo(qk.y), k3 = bfhi(qk.y);
      const float v0 = bflo(qv.x), v1 = bfhi(qv.x), v2 = bflo(qv.y), v3 = bfhi(qv.y);
      const float w0 = bflo(qw.x), w1 = bfhi(qw.x), w2 = bflo(qw.y), w3 = bfhi(qw.y);
      const float a0 = bflo(qa.x), a1 = bfhi(qa.x), a2 = bflo(qa.y), a3 = bfhi(qa.y);
      rc[0] += r0 * c_r.x; rc[1] += r1 * c_r.y; rc[2] += r2 * c_r.z; rc[3] += r3 * c_r.w;
      kc[0] += k0 * c_k.x; kc[1] += k1 * c_k.y; kc[2] += k2 * c_k.z; kc[3] += k3 * c_k.w;
      vc[0] += v0 * c_v.x; vc[1] += v1 * c_v.y; vc[2] += v2 * c_v.z; vc[3] += v3 * c_v.w;
      xwv[0] += w0 * c_w.x; xwv[1] += w1 * c_w.y; xwv[2] += w2 * c_w.z; xwv[3] += w3 * c_w.w;
      xav[0] += a0 * c_a.x; xav[1] += a1 * c_a.y; xav[2] += a2 * c_a.z; xav[3] += a3 * c_a.w;
    }
    float kkv[4], ss = 0.f;
#pragma unroll
    for (int c = 0; c < 4; ++c) {
      kkv[c] = kc[c] * kkw[c];
      ss += kkv[c] * kkv[c];
    }
    ss = allsum16(ss);
    const float kn = rsqrtf(fmaxf(ss, 1e-24f));
    *(float4*)(S + ts * 64 + ch0) = make_float4(rc[0], rc[1], rc[2], rc[3]);
    *(float4*)(S + 2048 + ts * 64 + ch0) = make_float4(kc[0], kc[1], kc[2], kc[3]);
    *(float4*)(S + 3072 + ts * 64 + ch0) = make_float4(vc[0], vc[1], vc[2], vc[3]);
    *(float4*)(S + 4096 + ts * 64 + ch0) = make_float4(-kkv[0] * kn, -kkv[1] * kn, -kkv[2] * kn, -kkv[3] * kn);
    *(uint2*)(xwb + ts * 144 + ch0 * 2) = make_uint2(pack2(tanhf_(xwv[0]), tanhf_(xwv[1])), pack2(tanhf_(xwv[2]), tanhf_(xwv[3])));
    *(uint2*)(xab + ts * 144 + ch0 * 2) = make_uint2(pack2(xav[0], xav[1]), pack2(xav[2], xav[3]));
  };
  auto stage2_mfma = [&]() {
    f32x16 acc;
#pragma unroll
    for (int i = 0; i < 16; ++i) acc[i] = 0.f;
    const char* asrc = (mat ? xab : xwb) + (lr & 15) * 144 + lh * 16;
#pragma unroll
    for (int ks = 0; ks < 4; ++ks) {
      bf16x8 af = *(const bf16x8*)(asrc + ks * 32);
      acc = MFMA(af, wfr[ks], acc);
    }
    return acc;
  };
  auto stage2_elem = [&](float* S, const f32x16& acc) {
    if (mat == 0) {
#pragma unroll
      for (int i = 0; i < 8; ++i) {
        const int tk = (i & 3) + 8 * (i >> 2) + 4 * lh;
        float x = -(lbias + acc[i]);
        float sp = x > 20.f ? x : (__builtin_amdgcn_logf(1.f + __expf(x)) * 0.6931471805599453f);
        S[1024 + tk * 64 + lch] = __expf(-__expf(-sp - 0.5f));
      }
    } else {
#pragma unroll
      for (int i = 0; i < 8; ++i) {
        const int tk = (i & 3) + 8 * (i >> 2) + 4 * lh;
        float a = sigmoidf_(lbias + acc[i]);
        float kcv = S[2048 + tk * 64 + lch], kkn = -S[4096 + tk * 64 + lch];
        S[2048 + tk * 64 + lch] = kcv * (1.f + (a - 1.f) * lka);
        S[5120 + tk * 64 + lch] = kkn * a;
      }
    }
  };
  auto stage2b = [&](float* S, int cn) {
    const int t = dir ? (L - 1 - (cn * 16 + ts)) : (cn * 16 + ts);
    float4 r4 = *(const float4*)(S + ts * 64 + ch0), w4 = *(const float4*)(S + 1024 + ts * 64 + ch0);
    float4 k4 = *(const float4*)(S + 2048 + ts * 64 + ch0), b4 = *(const float4*)(S + 5120 + ts * 64 + ch0);
    *(float4*)(S + 6144 + ts * 64 + ch0) = make_float4(w4.x * r4.x, w4.y * r4.y, w4.z * r4.z, w4.w * r4.w);
    float brp = b4.x * r4.x + b4.y * r4.y + b4.z * r4.z + b4.w * r4.w;
    float krp = k4.x * r4.x + k4.y * r4.y + k4.z * r4.z + k4.w * r4.w;
    float bsum = r4.x * k4.x * rkw[0] + r4.y * k4.y * rkw[1] + r4.z * k4.z * rkw[2] + r4.w * k4.w * rkw[3];
    brp = allsum16(brp);
    krp = allsum16(krp);
    bsum = allsum16(bsum);
    float* d1 = part == 0 ? S + 7168 + ts : dummy + (tid & 63);
    float* d2 = part == 0 ? S + 7184 + ts : dummy + 64 + (tid & 63);
    *d1 = brp;
    *d2 = krp;
    if (part == 0 && rbase == 0) BON[((size_t)(s0 + t) * 8 + head) * 2 + dir] = bsum;
  };
  f2 St0 = (f2)(0.f), St1 = (f2)(0.f);
  float4 a4, w4, b4, k4, q4;
  float vv, brs, krs, ykeep = 0.f;
  auto loadstep = [&](const float* C, int s) {
    const float* pc = C + 4096 + s * 64 + 4 * cg_;
    a4 = *(const float4*)(pc);
    w4 = *(const float4*)(pc - 3072);
    b4 = *(const float4*)(pc + 1024);
    k4 = *(const float4*)(pc - 2048);
    q4 = *(const float4*)(pc + 2048);
    vv = C[3072 + s * 64 + row];
    brs = C[7168 + s];
    krs = C[7184 + s];
  };
  auto step = [&](const float* C, int s) {
    const float4 ca = a4, cw4 = w4, cb = b4, ck = k4, cq = q4;
    const float cv = vv, cbr = brs, ckr = krs;
    if (s < 15) loadstep(C, s + 1);
    const f2 a01 = {ca.x, ca.y}, a23 = {ca.z, ca.w}, w01 = {cw4.x, cw4.y}, w23 = {cw4.z, cw4.w};
    const f2 b01 = {cb.x, cb.y}, b23 = {cb.z, cb.w}, k01 = {ck.x, ck.y}, k23 = {ck.z, ck.w};
    const f2 q01 = {cq.x, cq.y}, q23 = {cq.z, cq.w};
    f2 ta = St0 * a01 + St1 * a23;
    f2 ty = St0 * q01 + St1 * q23;
    float sai = allsum16(ta.x + ta.y);
    float ywi = allsum16(ty.x + ty.y);
    const float yo = ywi + sai * cbr + cv * ckr;
    const f2 sv2 = {sai, sai}, vv2 = {cv, cv};
    St0 = St0 * w01 + sv2 * b01 + vv2 * k01;
    St1 = St1 * w23 + sv2 * b23 + vv2 * k23;
    ykeep = (cg_ == s) ? yo : ykeep;
  };
  auto store_y = [&](int ci) {
    const int tt = dir ? (L - 1 - (ci * 16 + cg_)) : (ci * 16 + cg_);
    Y[(size_t)(s0 + tt) * 512 + head * 64 + row] = tobf(ykeep);
  };
  const int nchunks = L / 16;
  prefetch(0);
  __syncthreads();
  stage1(SB);
  __syncthreads();
  {
    f32x16 acc = stage2_mfma();
    stage2_elem(SB, acc);
  }
  __syncthreads();
  prefetch(1);
  stage2b(SB, 0);
  __syncthreads();
#pragma unroll 1
  for (int ci = 0; ci + 1 < nchunks; ++ci) {
    const float* C = SB + (ci & 1) * 7200;
    float* N = SB + ((ci + 1) & 1) * 7200;
    loadstep(C, 0);
    stage1(N);
    step(C, 0); step(C, 1); step(C, 2); step(C, 3); step(C, 4);
    __syncthreads();
    {
      f32x16 acc = stage2_mfma();
      step(C, 5); step(C, 6);
      stage2_elem(N, acc);
      step(C, 7); step(C, 8); step(C, 9);
    }
    __syncthreads();
    {
      const int c2 = ci + 2 < nchunks ? ci + 2 : nchunks - 1;
      prefetch(c2);
    }
    step(C, 10);
    stage2b(N, ci + 1);
    step(C, 11); step(C, 12); step(C, 13); step(C, 14); step(C, 15);
    store_y(ci);
    __syncthreads();
  }
  {
    const int ci = nchunks - 1;
    const float* C = SB + (ci & 1) * 7200;
    loadstep(C, 0);
#pragma unroll
    for (int s = 0; s < 16; ++s) step(C, s);
    store_y(ci);
  }
  __syncthreads();
}

DI void phase_post(const Params& p, int layer, char* smem) {
  const int tid = tidx();
  float* on = (float*)smem;
  float* xgs = on + 16 * 512;
  const u16* YF = (const u16*)(p.ws + OFF_YF);
  const u16* YB = (const u16*)(p.ws + OFF_YB);
  const u16* VR = (const u16*)(p.ws + OFF_VR);
  const u16* XG = (const u16*)(p.ws + OFF_XG);
  const float* BON = (const float*)(p.ws + OFF_BON);
  u16* ORW = (u16*)(p.ws + OFF_ORW);
  const float* cw = p.rw_conv + (size_t)layer * 3 * RW_COLS;
  const float* g2 = p.rw_g2 + (size_t)layer * 160 * 512;
  const float* lw = p.rw_lnx_w + layer * 512;
  const float* lb = p.rw_lnx_b + layer * 512;
  float* wt = xgs + 16 * 160;
  for (int idx = tid; idx < 2560; idx += 256) {
    const int a = idx >> 9, c = idx & 511;
    wt[idx] = a < 3 ? cw[a * RW_COLS + 1024 + c] : (a == 3 ? lw[c] : lb[c]);
  }
  float* wx = wt + 2560;
  for (int idx = tid; idx < 480; idx += 256) wx[idx] = cw[(idx / 160) * RW_COLS + 1792 + (idx % 160)];
  __syncthreads();
  for (int item = blockIdx.x; item < T / 16; item += gridDim.x) {
    const int tok0 = item * 16;
    const int seq = tok_seq(tok0), s0 = seq_start(seq), L = seq_len(seq);
    {
      u16 xm[10], x0[10], xp[10];
#pragma unroll
      for (int it = 0; it < 10; ++it) {
        const int idx = tid + 256 * it, s = idx / 160, j = idx - s * 160;
        const int tok = tok0 + s, t = tok - s0;
        const int tokm = t > 0 ? tok - 1 : tok, tokp = t + 1 < L ? tok + 1 : tok;
        xm[it] = XG[(size_t)tokm * 160 + j];
        x0[it] = XG[(size_t)tok * 160 + j];
        xp[it] = XG[(size_t)tokp * 160 + j];
      }
#pragma unroll
      for (int it = 0; it < 10; ++it) {
        const int idx = tid + 256 * it, s = idx / 160, j = idx - s * 160;
        const int t = tok0 + s - s0;
        const float mkm = t > 0 ? 1.f : 0.f, mkp = t + 1 < L ? 1.f : 0.f;
        const float acc = bf1(xm[it]) * mkm * wx[j] + bf1(x0[it]) * wx[160 + j] + bf1(xp[it]) * mkp * wx[320 + j];
        xgs[idx] = sigmoidf_(acc);
      }
    }
    {
      const int s = tid >> 4, part = tid & 15;
      const int tok = tok0 + s, t = tok - s0;
      const int tokm = t > 0 ? tok - 1 : tok, tokp = t + 1 < L ? tok + 1 : tok;
      const float mkm = t > 0 ? 1.f : 0.f, mkp = t + 1 < L ? 1.f : 0.f;
      uint2 uf[8], ub[8], vm[8], v0[8], vp[8];
      float bn[8];
#pragma unroll
      for (int hd = 0; hd < 8; ++hd) {
        const int gc0 = hd * 64 + part * 4;
        uf[hd] = *(const uint2*)(YF + (size_t)tok * 512 + gc0);
        ub[hd] = *(const uint2*)(YB + (size_t)tok * 512 + gc0);
        vm[hd] = *(const uint2*)(VR + (size_t)tokm * 512 + gc0);
        v0[hd] = *(const uint2*)(VR + (size_t)tok * 512 + gc0);
        vp[hd] = *(const uint2*)(VR + (size_t)tokp * 512 + gc0);
        bn[hd] = BON[((size_t)tok * 8 + hd) * 2] + BON[((size_t)tok * 8 + hd) * 2 + 1];
      }
#pragma unroll
      for (int hd = 0; hd < 8; ++hd) {
        const int gc0 = hd * 64 + part * 4;
        float y[4] = {bflo(uf[hd].x) + bflo(ub[hd].x), bfhi(uf[hd].x) + bfhi(ub[hd].x), bflo(uf[hd].y) + bflo(ub[hd].y), bfhi(uf[hd].y) + bfhi(ub[hd].y)};
        float sum = allsum16(y[0] + y[1] + y[2] + y[3]);
        float mu = sum * (1.f / 64.f);
        float q = 0.f;
#pragma unroll
        for (int c = 0; c < 4; ++c) q += (y[c] - mu) * (y[c] - mu);
        q = allsum16(q);
        float rstd = rsqrtf(q * (1.f / 64.f) + GN_EPS);
        const float4 c0 = *(const float4*)(wt + gc0), c1 = *(const float4*)(wt + 512 + gc0), c2 = *(const float4*)(wt + 1024 + gc0);
        const float4 w4 = *(const float4*)(wt + 1536 + gc0), b4 = *(const float4*)(wt + 2048 + gc0);
        float vc[4];
        vc[0] = bflo(vm[hd].x) * mkm * c0.x + bflo(v0[hd].x) * c1.x + bflo(vp[hd].x) * mkp * c2.x;
        vc[1] = bfhi(vm[hd].x) * mkm * c0.y + bfhi(v0[hd].x) * c1.y + bfhi(vp[hd].x) * mkp * c2.y;
        vc[2] = bflo(vm[hd].y) * mkm * c0.z + bflo(v0[hd].y) * c1.z + bflo(vp[hd].y) * mkp * c2.z;
        vc[3] = bfhi(vm[hd].y) * mkm * c0.w + bfhi(v0[hd].y) * c1.w + bfhi(vp[hd].y) * mkp * c2.w;
        const float wv[4] = {w4.x, w4.y, w4.z, w4.w}, bv[4] = {b4.x, b4.y, b4.z, b4.w};
#pragma unroll
        for (int c = 0; c < 4; ++c) on[s * 512 + gc0 + c] = (y[c] - mu) * rstd * wv[c] + bv[c] + bn[hd] * vc[c];
      }
    }
    __syncthreads();
    float ga[16][2];
#pragma unroll
    for (int s = 0; s < 16; ++s) ga[s][0] = ga[s][1] = 0.f;
    float wa[8], wb[8];
#pragma unroll
    for (int e = 0; e < 4; ++e) {
      wa[e] = g2[(size_t)e * 512 + tid];
      wa[4 + e] = g2[(size_t)e * 512 + tid + 256];
    }
#pragma unroll 1
    for (int j = 0; j < 160; j += 8) {
#pragma unroll
      for (int e = 0; e < 4; ++e) {
        wb[e] = g2[(size_t)(j + 4 + e) * 512 + tid];
        wb[4 + e] = g2[(size_t)(j + 4 + e) * 512 + tid + 256];
      }
#pragma unroll
      for (int s = 0; s < 16; ++s) {
        float4 xv = *(const float4*)(xgs + s * 160 + j);
        ga[s][0] += xv.x * wa[0] + xv.y * wa[1] + xv.z * wa[2] + xv.w * wa[3];
        ga[s][1] += xv.x * wa[4] + xv.y * wa[5] + xv.z * wa[6] + xv.w * wa[7];
      }
      if (j + 8 < 160) {
#pragma unroll
        for (int e = 0; e < 4; ++e) {
          wa[e] = g2[(size_t)(j + 8 + e) * 512 + tid];
          wa[4 + e] = g2[(size_t)(j + 8 + e) * 512 + tid + 256];
        }
      }
#pragma unroll
      for (int s = 0; s < 16; ++s) {
        float4 xv = *(const float4*)(xgs + s * 160 + j + 4);
        ga[s][0] += xv.x * wb[0] + xv.y * wb[1] + xv.z * wb[2] + xv.w * wb[3];
        ga[s][1] += xv.x * wb[4] + xv.y * wb[5] + xv.z * wb[6] + xv.w * wb[7];
      }
    }
#pragma unroll
    for (int s = 0; s < 16; ++s) {
      ORW[(size_t)(tok0 + s) * 512 + tid] = tobf(on[s * 512 + tid] * ga[s][0]);
      ORW[(size_t)(tok0 + s) * 512 + tid + 256] = tobf(on[s * 512 + tid + 256] * ga[s][1]);
    }
    __syncthreads();
  }
}

DI void phase_merge(const Params& p, int layer, char* smem) {
  const int tid = tidx(), lrow = tid >> 3;
  const u16* W = (const u16*)(p.ws + OFF_WIN) + (size_t)layer * IN_COLS * 1024;
  const u16* WB = (const u16*)(p.ws + OFF_WBR) + (size_t)layer * 3 * 1024 * 512;
  const float* rs = (const float*)(smem + AUX);
  u16* MG = (u16*)(p.ws + OFF_MERGED);
  for (int id = blockIdx.x; id < 384 * 8; id += gridDim.x) {
    int mt, nt;
    decode_tile(id, 384, 8, mt, nt);
    const int tok0 = mt * 128;
    f32x16 res[2][2];
    zero_acc(res);
#pragma unroll 1
    for (int br = 0; br < 3; ++br) {
      f32x16 acc[2][2];
      zero_acc(acc);
      LoadF32c<32 * 1024> la;
      LoadBFc<32 * 1024> lb;
      la.base = xrow(p, layer, tok0) + (size_t)lrow * 1024;
      lb.base = W + (size_t)(4000 + br * 1024 + nt * 128 + lrow) * 1024;
#pragma unroll
      for (int i = 0; i < 4; ++i) la.ssq[i] = 0.f;
      gemm_mainloop<1>(la, lb, 16, acc, smem);
      if (br == 0) write_rstd(la, smem);
      uint32_t gpk[2][2][8];
      {
        const int lane = tid & 63, wave = tid >> 6, wm = wave & 1, h = lane >> 5;
#pragma unroll
        for (int a = 0; a < 2; ++a)
#pragma unroll
          for (int b = 0; b < 2; ++b)
#pragma unroll
            for (int i = 0; i < 16; i += 2) {
              int row = wm * 64 + a * 32 + (i & 3) + 8 * (i >> 2) + 4 * h;
              gpk[a][b][i >> 1] = pack2a(sigmoidf_(acc[a][b][i] * rs[row]), sigmoidf_(acc[a][b][i + 1] * rs[row + 1]));
            }
      }
      zero_acc(acc);
      LoadBFc<32 * 512> la2, lb2;
      const u16* osrc = (const u16*)(p.ws + (br == 0 ? OFF_QN : (br == 1 ? OFF_ORW : OFF_QM)));
      la2.base = osrc + (size_t)(tok0 + lrow) * 512;
      lb2.base = WB + (size_t)br * 1024 * 512 + (size_t)(nt * 128 + lrow) * 512;
      gemm_mainloop<1>(la2, lb2, 8, acc, smem);
#pragma unroll
      for (int a = 0; a < 2; ++a)
#pragma unroll
        for (int b = 0; b < 2; ++b)
#pragma unroll
          for (int i = 0; i < 16; i += 2) {
            res[a][b][i] += bflo(gpk[a][b][i >> 1]) * acc[a][b][i];
            res[a][b][i + 1] += bfhi(gpk[a][b][i >> 1]) * acc[a][b][i + 1];
          }
    }
    epi_foreach(res, [&](int row, int col, float v) { MG[(size_t)(tok0 + row) * 1024 + nt * 128 + col] = tobfa(v); });
    __syncthreads();
  }
}

DI void phase_outproj(const Params& p, int layer, char* smem) {
  const int tid = tidx(), lrow = tid >> 3;
  const u16* W = (const u16*)(p.ws + OFF_WOUT) + (size_t)layer * 1024 * 1024;
  const u16* MG = (const u16*)(p.ws + OFF_MERGED);
  typedef LoadBFc<32 * 1024> LT;
  gemm_tiles<2, LT, LT>(
      16, blockIdx.x, gridDim.x, 384 * 8,
      [&](int id, LT& la, LT& lb) {
        int mt, nt;
        decode_tile(id, 384, 8, mt, nt);
        la.base = MG + (size_t)(mt * 128 + lrow) * 1024;
        lb.base = W + (size_t)(nt * 128 + lrow) * 1024;
      },
      [&](int id, f32x16 (&acc)[2][2], LT&) {
        int mt, nt;
        decode_tile(id, 384, 8, mt, nt);
        const int tok0 = mt * 128;
        const float* xb = xrow(p, layer, tok0) + nt * 128;
        float* ob = p.out + (size_t)tok0 * 1024 + nt * 128;
        u16* hb = (u16*)(p.ws + OFF_XB) + (size_t)tok0 * 1024 + nt * 128;
        epi_foreach(acc, [&](int row, int col, float v) {
          const float xn = xb[(size_t)row * 1024 + col] + v;
          ob[(size_t)row * 1024 + col] = xn;
          hb[(size_t)row * 1024 + col] = tobf(xn);
        });
      },
      smem);
}

DI void phase_rowstats(const Params& p) {
  const int tid_ = tidx();
  const int lane = tid_ & 63, wave = tid_ >> 6;
  float* RST = (float*)(p.ws + OFF_RST);
  const int rstride = gridDim.x * 4;
  for (int row = blockIdx.x * 4 + wave; row < T; row += 2 * rstride) {
    const int row2 = row + rstride < T ? row + rstride : row;
    const float4* px = (const float4*)(p.out + (size_t)row * 1024);
    const float4* py = (const float4*)(p.out + (size_t)row2 * 1024);
    float4 va[4], vb[4];
#pragma unroll
    for (int i = 0; i < 4; ++i) { va[i] = px[lane + 64 * i]; vb[i] = py[lane + 64 * i]; }
    float ss = 0.f, st = 0.f;
#pragma unroll
    for (int i = 0; i < 4; ++i) {
      ss += va[i].x * va[i].x + va[i].y * va[i].y + va[i].z * va[i].z + va[i].w * va[i].w;
      st += vb[i].x * vb[i].x + vb[i].y * vb[i].y + vb[i].z * vb[i].z + vb[i].w * vb[i].w;
    }
#pragma unroll
    for (int o = 32; o >= 1; o >>= 1) { ss += __shfl_xor(ss, o); st += __shfl_xor(st, o); }
    if (lane == 0) {
      RST[row] = rsqrtf(ss * (1.f / 1024.f) + RMS_EPS);
      RST[row2] = rsqrtf(st * (1.f / 1024.f) + RMS_EPS);
    }
  }
}

DI void phase_up(const Params& p, int layer, char* smem) {
  const int tid = tidx(), lrow = tid >> 3;
  const u16* W = (const u16*)(p.ws + OFF_WUP) + (size_t)layer * 5632 * 1024;
  float* rs = (float*)(smem + AUX);
  const float* RST = (const float*)(p.ws + OFF_RST);
  const float* cw = p.ffn_conv + (size_t)layer * 3 * 5632;
  const float* cb = p.ffn_conv_b + (size_t)layer * 5632;
  u16* ACT = (u16*)(p.ws + OFF_FFACT);
  u16* us = (u16*)(smem + 36864);
  typedef LoadBFv<32 * 1024> LTA;
  auto tile_geom = [&](int id, int& nt, int& s0, int& L, int& tbase) {
    int mt;
    decode_tile(id, 400, 44, mt, nt);
    int seq, ti;
    if (mt < 264) { seq = mt / 66; ti = mt % 66; }
    else { seq = 4 + (mt - 264) / 17; ti = (mt - 264) % 17; }
    s0 = seq_start(seq);
    L = seq_len(seq);
    tbase = ti * 126 - 1;
  };
  typedef LoadBF2c<32 * 1024> LTB;
  gemm_tiles<2, LTA, LTB>(
      16, blockIdx.x, gridDim.x, 400 * 44,
      [&](int id, LTA& la, LTB& lb) {
        int nt, s0, L, tbase;
        tile_geom(id, nt, s0, L, tbase);
        la.base = (const u16*)(p.ws + OFF_XB) + (long)(s0 + tbase + lrow) * 1024;
        la.valid = 0u;
        la.voff = 0;
        lb.base0 = W + (size_t)(nt * 64 + lrow) * 1024;
        lb.base1 = W + (size_t)(2816 + nt * 64 + lrow) * 1024;
#pragma unroll
        for (int i = 0; i < 4; ++i) {
          int t = tbase + lrow + 32 * i;
          if (t >= 0 && t < L) { la.valid |= 1u << i; la.voff = i * 32 * 1024; }
        }
      },
      [&](int id, f32x16 (&acc)[2][2], LTA& la) {
        int nt, s0, L, tbase;
        tile_geom(id, nt, s0, L, tbase);
        const int c8 = (tid & 7) * 8, ch = nt * 64 + c8;
        float wv[3][8], wg[3][8], bv8[8], bg8[8];
#pragma unroll
        for (int d = 0; d < 3; ++d) {
          *(float4*)&wv[d][0] = *(const float4*)(cw + d * 5632 + ch);
          *(float4*)&wv[d][4] = *(const float4*)(cw + d * 5632 + ch + 4);
          *(float4*)&wg[d][0] = *(const float4*)(cw + d * 5632 + 2816 + ch);
          *(float4*)&wg[d][4] = *(const float4*)(cw + d * 5632 + 2816 + ch + 4);
        }
        *(float4*)&bv8[0] = *(const float4*)(cb + ch);
        *(float4*)&bv8[4] = *(const float4*)(cb + ch + 4);
        *(float4*)&bg8[0] = *(const float4*)(cb + 2816 + ch);
        *(float4*)&bg8[4] = *(const float4*)(cb + 2816 + ch + 4);
        if (tid < 128) {
          const int t = tbase + tid;
          rs[tid] = (t >= 0 && t < L) ? RST[s0 + t] : 0.f;
        }
        __syncthreads();
        epi_foreach(acc, [&](int row, int col, float v) { us[row * 136 + col] = tobf(v * rs[row]); });
        __syncthreads();
#pragma unroll 1
        for (int rr = 1 + (tid >> 3); rr <= 126; rr += 32) {
          const int t = tbase + rr;
          if (t < L) {
            float val[8], gt[8];
#pragma unroll
            for (int e = 0; e < 8; ++e) { val[e] = bv8[e]; gt[e] = bg8[e]; }
#pragma unroll
            for (int d = 0; d < 3; ++d) {
              const uint4 uv = *(const uint4*)(us + (rr - 1 + d) * 136 + c8);
              const uint4 ug = *(const uint4*)(us + (rr - 1 + d) * 136 + 64 + c8);
              val[0] += bflo(uv.x) * wv[d][0]; val[1] += bfhi(uv.x) * wv[d][1]; val[2] += bflo(uv.y) * wv[d][2]; val[3] += bfhi(uv.y) * wv[d][3];
              val[4] += bflo(uv.z) * wv[d][4]; val[5] += bfhi(uv.z) * wv[d][5]; val[6] += bflo(uv.w) * wv[d][6]; val[7] += bfhi(uv.w) * wv[d][7];
              gt[0] += bflo(ug.x) * wg[d][0]; gt[1] += bfhi(ug.x) * wg[d][1]; gt[2] += bflo(ug.y) * wg[d][2]; gt[3] += bfhi(ug.y) * wg[d][3];
              gt[4] += bflo(ug.z) * wg[d][4]; gt[5] += bfhi(ug.z) * wg[d][5]; gt[6] += bflo(ug.w) * wg[d][6]; gt[7] += bfhi(ug.w) * wg[d][7];
            }
            float o[8];
#pragma unroll
            for (int e = 0; e < 8; ++e) o[e] = gt[e] * sigmoidf_(gt[e]) * val[e];
            *(uint4*)(ACT + (size_t)(s0 + t) * DFF + ch) = make_uint4(pack2(o[0], o[1]), pack2(o[2], o[3]), pack2(o[4], o[5]), pack2(o[6], o[7]));
          }
        }
        __syncthreads();
      },
      smem);
}

DI void phase_down(const Params& p, int layer, char* smem) {
  const int tid = tidx(), lrow = tid >> 3;
  const u16* W = (const u16*)(p.ws + OFF_WDN) + (size_t)layer * 1024 * DFF;
  const u16* ACT = (const u16*)(p.ws + OFF_FFACT);
  for (int id = blockIdx.x; id < 384 * 8; id += gridDim.x) {
    int mt, nt;
    decode_tile(id, 384, 8, mt, nt);
    const int tok0 = mt * 128;
    f32x16 acc[2][2];
    zero_acc(acc);
    LoadBFc<32 * DFF> la, lb;
    la.base = ACT + (size_t)(tok0 + lrow) * DFF;
    lb.base = W + (size_t)(nt * 128 + lrow) * DFF;
    gemm_mainloop<2>(la, lb, 44, acc, smem);
    epi_foreach(acc, [&](int row, int col, float v) {
      size_t o = (size_t)(tok0 + row) * 1024 + nt * 128 + col;
      p.out[o] += v;
    });
  }
}

DI void phase_final(const Params& p) {
  const int tid_ = tidx(); const int lane = tid_ & 63, wave = tid_ >> 6;
  const int rstride = gridDim.x * 4;
  float4 g[4];
#pragma unroll
  for (int i = 0; i < 4; ++i) g[i] = ((const float4*)p.final_norm)[lane + 64 * i];
  for (int row = blockIdx.x * 4 + wave; row < T; row += 2 * rstride) {
    const int row2 = row + rstride < T ? row + rstride : row;
    float4* px = (float4*)(p.out + (size_t)row * 1024);
    float4* py = (float4*)(p.out + (size_t)row2 * 1024);
    float4 va[4], vb[4];
#pragma unroll
    for (int i = 0; i < 4; ++i) { va[i] = px[lane + 64 * i]; vb[i] = py[lane + 64 * i]; }
    float ss = 0.f, st = 0.f;
#pragma unroll
    for (int i = 0; i < 4; ++i) {
      ss += va[i].x * va[i].x + va[i].y * va[i].y + va[i].z * va[i].z + va[i].w * va[i].w;
      st += vb[i].x * vb[i].x + vb[i].y * vb[i].y + vb[i].z * vb[i].z + vb[i].w * vb[i].w;
    }
#pragma unroll
    for (int o = 32; o >= 1; o >>= 1) { ss += __shfl_xor(ss, o); st += __shfl_xor(st, o); }
    const float ra = rsqrtf(ss * (1.f / 1024.f) + RMS_EPS), rb = rsqrtf(st * (1.f / 1024.f) + RMS_EPS);
#pragma unroll
    for (int i = 0; i < 4; ++i) {
      px[lane + 64 * i] = make_float4(va[i].x * ra * g[i].x, va[i].y * ra * g[i].y, va[i].z * ra * g[i].z, va[i].w * ra * g[i].w);
      py[lane + 64 * i] = make_float4(vb[i].x * rb * g[i].x, vb[i].y * rb * g[i].y, vb[i].z * rb * g[i].z, vb[i].w * rb * g[i].w);
    }
  }
}

constexpr int NPHASE = 20;
DI void run_phase(const Params& p, int ph, char* smem) {
  if (ph == 0) { phase_convert(p, smem); return; }
  if (ph == NPHASE - 1) { phase_final(p); return; }
  const int layer = (ph - 1) / 9, sub = (ph - 1) % 9;
  switch (sub) {
#define PH_ON(k) (!defined(ONLY) || ONLY == (k))
#if !defined(ONLY) || ONLY == 0
    case 0: phase_inproj(p, layer, smem); break;
#endif
#if !defined(ONLY) || ONLY == 1
    case 1:
      for (int it = blockIdx.x; it < 6144; it += gridDim.x) na_item(p, layer, it, smem);
      break;
#endif
#if !defined(ONLY) || ONLY == 2 || ONLY == 12
    case 2: {
      int* cnt = (int*)(p.ws + OFF_CNT) + layer;
      int* sh = (int*)(smem + AUX + 1024);
#if !defined(ONLY) || ONLY == 2
      for (int ci = blockIdx.x; ci < 384; ci += gridDim.x) {
        if (ci < 256) scan_quarter(p, layer, ci >> 2, (ci & 3) * 16, smem);
        else scan_item<4>(p, layer, 64 + (ci - 256), 0, smem);
      }
#endif
      while (true) {
        __syncthreads();
        if (threadIdx.x == 0) *sh = atomicAdd(cnt, 1);
        __syncthreads();
        const int it = *sh;
        if (it >= 1536) break;
#if !defined(ONLY) || ONLY == 12
        mem_item(p, it, smem);
#endif
      }
    } break;
#endif
#if !defined(ONLY) || ONLY == 3
    case 3: phase_post(p, layer, smem); break;
#endif
#if !defined(ONLY) || ONLY == 4
    case 4: phase_merge(p, layer, smem); break;
#endif
#if !defined(ONLY) || ONLY == 5
    case 5: phase_outproj(p, layer, smem); break;
#endif
    case 6: phase_rowstats(p); break;
#if !defined(ONLY) || ONLY == 6
    case 7: phase_up(p, layer, smem); break;
#endif
#if !defined(ONLY) || ONLY == 7
    case 8: phase_down(p, layer, smem); break;
#endif
  }
}

__global__ void __launch_bounds__(256, 2) mega(Params p) {
  extern __shared__ __attribute__((aligned(16))) char smem[];
#if SINGLE_LAUNCH
  cg::grid_group grid = cg::this_grid();
#pragma unroll 1
  for (int ph = p.phase_lo; ph < p.phase_hi; ++ph) {
    run_phase(p, ph, smem);
    if (ph + 1 < p.phase_hi) {
      asm volatile("s_waitcnt vmcnt(0)" ::: "memory");
      __syncthreads();
      grid.sync();
    }
  }
#else
  run_phase(p, p.phase_lo, smem);
#endif
}

extern "C" void kernel_launch(void* const* d_in, const int* in_sizes, int n_in, void* d_out, int out_size, void* d_ws,
                              size_t ws_size, hipStream_t stream) {
  static int grid_blocks = 0;
  if (!grid_blocks) {
    int dev = 0, cus = 0, per_cu = 0;
    hipGetDevice(&dev);
    hipDeviceGetAttribute(&cus, hipDeviceAttributeMultiprocessorCount, dev);
    hipFuncSetAttribute((const void*)mega, hipFuncAttributeMaxDynamicSharedMemorySize, LDS_BYTES);
    hipOccupancyMaxActiveBlocksPerMultiprocessor(&per_cu, (const void*)mega, 256, LDS_BYTES);
    if (per_cu > 2) per_cu = 2;
    if (per_cu < 1) per_cu = 1;
    grid_blocks = cus * per_cu;
  }
  Params p{};
  const float** pf = (const float**)&p;
  for (int i = 0; i < 28; ++i) pf[i] = (const float*)d_in[i];
  p.out = (float*)d_out;
  p.ws = (char*)d_ws;
  hipMemsetAsync((char*)d_ws + OFF_CNT, 0, 256, stream);
#if SINGLE_LAUNCH
  p.phase_lo = 0;
  p.phase_hi = NPHASE;
  void* args[] = {&p};
  hipError_t e = hipLaunchCooperativeKernel((const void*)mega, dim3(grid_blocks), dim3(256), args, LDS_BYTES, stream);
  if (e != hipSuccess) fprintf(stderr, "cooperative launch failed: %s (grid %d)\n", hipGetErrorString(e), grid_blocks);
#else
  for (int ph = 0; ph < NPHASE; ++ph) {
    p.phase_lo = ph;
    p.phase_hi = ph + 1;
    hipLaunchKernelGGL(mega, dim3(grid_blocks), dim3(256), LDS_BYTES, stream, p);
  }
#endif
}
```
